# Optimizing an MI355X kernel written in HIP

```python
import math
import jax, jax.numpy as jnp
from jax import lax
import numpy as np

D_MODEL = 1024
BATCH = 2
SEQ = 8192
DEPTH = 2

CTX_LEN = 256
GRID_W = 64
N_HEADS = 8
HEAD_DIM = 64
V_DIM = 2 * HEAD_DIM
QK_W = N_HEADS * 2 * HEAD_DIM
ATTN_WIDTH = N_HEADS * V_DIM
N_FGROUPS = 4
FGROUP_DIM = 128
FOURIER_WIDTH = N_FGROUPS * FGROUP_DIM
F_OFF = 2 * QK_W + ATTN_WIDTH
G_OFF = F_OFF + FOURIER_WIDTH
IN_WIDTH = G_OFF + 2 * D_MODEL
D_FF = 2816
AXIS_DIM = HEAD_DIM // 2
ROPE_BASE = 10000.0
Q_BLOCK = 128
N_MOD = 9
EPS = 1e-6

kernel_name = "hybrid_diffattn_fnet_macaron_dit"


def rms_norm(x, g):
    xf = x.astype(jnp.float32)
    y = xf * lax.rsqrt(jnp.mean(xf * xf, axis=-1, keepdims=True) + EPS)
    return (y * g.astype(jnp.float32)).astype(x.dtype)


def adaln_mod(cond, w_mod, b_mod):
    m = jax.nn.silu(cond) @ w_mod + b_mod
    return m.reshape(cond.shape[:-1] + (N_MOD, D_MODEL))


def modulate(x, m, i):
    shift = m[:, 3 * i][:, None]
    scale = m[:, 3 * i + 1][:, None]
    return x * (1 + scale) + shift


def swiglu(u, w_in, w_out):
    a, b = jnp.split(u @ w_in, 2, axis=-1)
    return (jax.nn.silu(a) * b) @ w_out


def ffn_sublayer(x, m, i, g, w_in, w_out):
    u = modulate(rms_norm(x, g), m, i)
    return x + 0.5 * m[:, 3 * i + 2][:, None] * swiglu(u, w_in, w_out)


def split_qkv(p):
    B, S = p.shape[:2]
    q = p[..., :QK_W].reshape(B, S, N_HEADS, 2, HEAD_DIM)
    k = p[..., QK_W:2 * QK_W].reshape(B, S, N_HEADS, 2, HEAD_DIM)
    v = p[..., 2 * QK_W:F_OFF].reshape(B, S, N_HEADS, V_DIM)
    return q, k, v


def rope_tables(S):
    ROWS = S // GRID_W
    row = jnp.broadcast_to(jnp.arange(ROWS, dtype=jnp.int32)[:, None], (ROWS, GRID_W)).reshape(S)
    col = jnp.broadcast_to(jnp.arange(GRID_W, dtype=jnp.int32)[None, :], (ROWS, GRID_W)).reshape(S)
    inv = 1.0 / (ROPE_BASE ** (jnp.arange(0, AXIS_DIM, 2, dtype=jnp.float32) / AXIS_DIM))

    def tab(pos):
        ang = pos.astype(jnp.float32)[:, None] * inv[None, :]
        ang = jnp.concatenate([ang, ang], axis=-1)
        return jnp.cos(ang), jnp.sin(ang)

    cr, sr = tab(row)
    cc, sc = tab(col)
    return cr, sr, cc, sc


def rotate(xh, cos, sin):
    cos = cos[None, :, None, None, :].astype(xh.dtype)
    sin = sin[None, :, None, None, :].astype(xh.dtype)
    x1, x2 = jnp.split(xh, 2, axis=-1)
    return xh * cos + jnp.concatenate([-x2, x1], axis=-1) * sin


def apply_rope2d(x, tabs):
    cr, sr, cc, sc = tabs
    return jnp.concatenate([rotate(x[..., :AXIS_DIM], cr, sr),
                            rotate(x[..., AXIS_DIM:], cc, sc)], axis=-1)


def diff_attend(q, k, v, lam):
    s = jnp.einsum("bqhcd,bkhcd->bhcqk", q, k).astype(jnp.float32) * (HEAD_DIM ** -0.5)
    p = jax.nn.softmax(s, axis=-1)
    a = p[:, :, 0] - lam * p[:, :, 1]
    return jnp.einsum("bhqk,bkhe->bqhe", a.astype(v.dtype), v)


def latent_diff_attention(q, k_all, v_all, lam):
    B, S = q.shape[:2]
    nb = S // Q_BLOCK
    qb = jnp.moveaxis(q.reshape(B, nb, Q_BLOCK, N_HEADS, 2, HEAD_DIM), 1, 0)
    out = lax.map(lambda blk: diff_attend(blk, k_all, v_all, lam), qb)
    return jnp.moveaxis(out, 0, 1).reshape(B, S, N_HEADS, V_DIM)


def fourier_mix(f):
    B, S = f.shape[:2]
    fg = f.reshape(B, S, N_FGROUPS, FGROUP_DIM).astype(jnp.float32)
    y = jnp.fft.fft2(fg, axes=(1, 3), norm="ortho").real
    return y.reshape(B, S, FOURIER_WIDTH).astype(f.dtype)


def mixer_merge(attn_heads, f, g_logits, lam_init, subln_g, w_attn_out, w_four_out, b_gate, w_o):
    B, S = attn_heads.shape[:2]
    a = (rms_norm(attn_heads, subln_g) * (1 - lam_init)).reshape(B, S, ATTN_WIDTH) @ w_attn_out
    fr = fourier_mix(f) @ w_four_out
    ga, gf = jnp.split(g_logits, 2, axis=-1)
    merged = jax.nn.sigmoid(ga + b_gate[0]) * a + jax.nn.sigmoid(gf + b_gate[1]) * fr
    return merged @ w_o


def setup_inputs(seed: int = 0) -> dict:
    key = jax.random.key(seed)
    ks = jax.random.split(key, 20)
    f32 = jnp.float32
    D = D_MODEL

    def nrm(k, shape, scale):
        return jax.random.normal(k, shape, f32) * scale

    return {
        "x": nrm(ks[0], (BATCH, SEQ, D), 1.0),
        "c": nrm(ks[1], (BATCH, D), 1.0),
        "ctx": nrm(ks[2], (BATCH, CTX_LEN, D), 1.0),
        "c_ctx": nrm(ks[3], (D,), 1.0),
        "w_mod": nrm(ks[4], (DEPTH, D, N_MOD * D), 0.5 * D ** -0.5),
        "b_mod": nrm(ks[5], (DEPTH, N_MOD * D), 0.01),
        "norm_g": 1.0 + nrm(ks[6], (DEPTH, 3, D), 0.1),
        "ffn_w_in": nrm(ks[7], (DEPTH, 2, D, 2 * D_FF), D ** -0.5),
        "ffn_w_out": nrm(ks[8], (DEPTH, 2, D_FF, D), D_FF ** -0.5),
        "w_in": nrm(ks[9], (DEPTH, D, IN_WIDTH), D ** -0.5),
        "b_gate": nrm(ks[10], (DEPTH, 2, D), 0.01),
        "lam_params": nrm(ks[11], (DEPTH, 4, HEAD_DIM), 0.1),
        "subln_g": 1.0 + nrm(ks[12], (DEPTH, V_DIM), 0.1),
        "w_attn_out": nrm(ks[13], (DEPTH, ATTN_WIDTH, D), ATTN_WIDTH ** -0.5),
        "w_four_out": nrm(ks[14], (DEPTH, FOURIER_WIDTH, D), FOURIER_WIDTH ** -0.5),
        "w_o": nrm(ks[15], (DEPTH, D, D), D ** -0.5),
        "final_g": 1.0 + nrm(ks[16], (D,), 0.1),
    }


def reference(x, c, ctx, c_ctx, w_mod, b_mod, norm_g, ffn_w_in, ffn_w_out, w_in, b_gate,
              lam_params, subln_g, w_attn_out, w_four_out, w_o, final_g):
    S = x.shape[1]
    tabs = rope_tables(S)
    x_lat = x
    x_ctx = ctx
    for l in range(DEPTH):
        last = l == DEPTH - 1
        lam_init = 0.8 - 0.6 * math.exp(-0.3 * l)
        lp = lam_params[l].astype(jnp.float32)
        lam = jnp.exp(jnp.sum(lp[0] * lp[1])) - jnp.exp(jnp.sum(lp[2] * lp[3])) + lam_init

        m_lat = adaln_mod(c, w_mod[l], b_mod[l])
        m_ctx = adaln_mod(c_ctx, w_mod[l], b_mod[l])[None]

        x_lat = ffn_sublayer(x_lat, m_lat, 0, norm_g[l, 0], ffn_w_in[l, 0], ffn_w_out[l, 0])
        x_ctx = ffn_sublayer(x_ctx, m_ctx, 0, norm_g[l, 0], ffn_w_in[l, 0], ffn_w_out[l, 0])

        u_lat = modulate(rms_norm(x_lat, norm_g[l, 1]), m_lat, 1)
        u_ctx = modulate(rms_norm(x_ctx, norm_g[l, 1]), m_ctx, 1)
        p_lat = u_lat @ w_in[l]
        q_l, k_l, v_l = split_qkv(p_lat)
        q_l = apply_rope2d(q_l, tabs)
        k_l = apply_rope2d(k_l, tabs)
        if last:
            kv_c = u_ctx @ w_in[l][:, QK_W:F_OFF]
            B = kv_c.shape[0]
            k_c = kv_c[..., :QK_W].reshape(B, CTX_LEN, N_HEADS, 2, HEAD_DIM)
            v_c = kv_c[..., QK_W:].reshape(B, CTX_LEN, N_HEADS, V_DIM)
        else:
            p_ctx = u_ctx @ w_in[l]
            q_c, k_c, v_c = split_qkv(p_ctx)

        k_all = jnp.concatenate([k_c, k_l], axis=1)
        v_all = jnp.concatenate([v_c, v_l], axis=1)
        attn_l = latent_diff_attention(q_l, k_all, v_all, lam)
        mix_l = mixer_merge(attn_l, p_lat[..., F_OFF:G_OFF], p_lat[..., G_OFF:], lam_init,
                            subln_g[l], w_attn_out[l], w_four_out[l], b_gate[l], w_o[l])
        x_lat = x_lat + m_lat[:, 5][:, None] * mix_l

        if not last:
            attn_c = diff_attend(q_c, k_c, v_c, lam)
            mix_c = mixer_merge(attn_c, p_ctx[..., F_OFF:G_OFF], p_ctx[..., G_OFF:], lam_init,
                                subln_g[l], w_attn_out[l], w_four_out[l], b_gate[l], w_o[l])
            x_ctx = x_ctx + m_ctx[:, 5][:, None] * mix_c
            x_ctx = ffn_sublayer(x_ctx, m_ctx, 2, norm_g[l, 2], ffn_w_in[l, 1], ffn_w_out[l, 1])

        x_lat = ffn_sublayer(x_lat, m_lat, 2, norm_g[l, 2], ffn_w_in[l, 1], ffn_w_out[l, 1])

    return rms_norm(x_lat, final_g)
```

```cpp
#include <hip/hip_runtime.h>
#include <hip/hip_cooperative_groups.h>
#include <cstdio>
#include <cstdint>
namespace cg = cooperative_groups;
namespace pg8 {
#define PG8_LAS __attribute__((address_space(3)))
typedef unsigned short bf16_t;
typedef short bf16x8 __attribute__((ext_vector_type(8)));
typedef float f32x4 __attribute__((ext_vector_type(4)));
typedef unsigned u32x4 __attribute__((ext_vector_type(4)));
constexpr int BM = 256, BK = 64, HALF = 128, HTB = HALF * BK * 2  , STAGE_BYTES = 8 * HTB, NXCD = 8, WGM = 8;

__host__ __device__ __forceinline__ int lds_byte(int r, int c) { const int st = (r >> 4) * 2 + (c >> 5), rr = r & 15, cc = c & 31, ob = rr * 64 + cc * 2; return st * 1024 + (ob ^ (((ob >> 9) & 1) << 5)); }
__host__ __device__ __forceinline__ void stage_rc(int b, int& R, int& C) { const int st = b / 1024, sb = b % 1024, swz = sb ^ (((sb >> 9) & 1) << 5); R = (st >> 1) * 16 + swz / 64; C = (st & 1) * 32 + (swz % 64) / 2; }
__host__ __device__ __forceinline__ int perm32(int rho) { const int n = rho >> 4, i = rho & 15; return 8 * (i >> 2) + 4 * n + (i & 3); }

struct Unit { int pm, pn; };
struct Gemm { const bf16_t* A; const bf16_t* Bt; int M, N, K; };

struct StaticOrder {
    int nM, nN, nwg, G, c;
    __host__ __device__ void init(int M, int N, int G_, int c_) { nM = M / BM; nN = N / BM; nwg = nM * nN; G = G_; c = c_; }
    __host__ __device__ bool next(int i, Unit& u) const {
        const long L = (long)i * G + c; if (L >= nwg) return false;
        int wgid = (int)L; { const int q = nwg / NXCD, r = nwg % NXCD, xcd = wgid % NXCD, off = wgid / NXCD; wgid = (xcd < r ? xcd * (q + 1) : r * (q + 1) + (xcd - r) * q) + off; }
        const int nig = WGM * nN, gid = wgid / nig, fm = gid * WGM, gsz = (nM - fm) < WGM ? (nM - fm) : WGM;
        u.pm = fm + ((wgid % nig) % gsz); u.pn = (wgid % nig) / gsz; return true;
    }
    __device__ __forceinline__ void a_ready(const Unit&) const {}
    __device__ __forceinline__ void done(const Unit&) const {}
};

typedef float f32x2_cv __attribute__((ext_vector_type(2))); typedef __bf16 bf16x2_cv __attribute__((ext_vector_type(2)));
__device__ __forceinline__ unsigned cvt_pk_bf16(float lo, float hi) { const f32x2_cv v = {lo, hi}; const bf16x2_cv b = __builtin_convertvector(v, bf16x2_cv); return __builtin_bit_cast(unsigned, b); }
typedef float f32x2 __attribute__((ext_vector_type(2)));
typedef struct { float x, y; } cs2_t;
typedef unsigned u32x2 __attribute__((ext_vector_type(2)));
__device__ __forceinline__ float sigm(float x) { return __builtin_amdgcn_rcpf(1.0f + __builtin_amdgcn_exp2f(-1.4426950408889634f * x)); }
__device__ __forceinline__ float bf2f(unsigned short h) { return __builtin_bit_cast(float, (unsigned)h << 16); }
constexpr int LATROWS = 16384, MTROWS = 16896, DFF = 2816;

struct EpiSwiGLU {
    static constexpr bool PERM = true, AFTER_DRAIN = false;
    bf16_t* H;
    __device__ __forceinline__ void operator()(const f32x4 (&acc)[2][2][4][2], const Unit& u, int wr, int wc, int fr, int fq) const {
        const int row0 = u.pm * BM + wr * 64 + fr, col0 = u.pn * 128 + wc * 32 + 8 * fq;
#pragma unroll
        for (int ai = 0; ai < 2; ++ai)
#pragma unroll
            for (int m = 0; m < 4; ++m) {
                bf16_t* p = H + (size_t)(row0 + ai * HALF + m * 16) * DFF + col0;
                const f32x4 a0 = acc[ai][0][m][0], a1 = acc[ai][0][m][1], b0 = acc[ai][1][m][0], b1 = acc[ai][1][m][1];
                float h[8];
#pragma unroll
                for (int j = 0; j < 4; ++j) { h[j] = a0[j] * sigm(a0[j]) * b0[j]; h[4 + j] = a1[j] * sigm(a1[j]) * b1[j]; }
                u32x4 w; w.x = cvt_pk_bf16(h[0], h[1]); w.y = cvt_pk_bf16(h[2], h[3]); w.z = cvt_pk_bf16(h[4], h[5]); w.w = cvt_pk_bf16(h[6], h[7]);
                *(u32x4*)p = w;
            }
    }
};
struct EpiResid {
    static constexpr bool PERM = false, AFTER_DRAIN = false;
    const float* base_lat; const float* base_ctx; float* out; const float* gate; float coef;
    __device__ __forceinline__ void operator()(const f32x4 (&acc)[2][2][4][2], const Unit& u, int wr, int wc, int fr, int fq) const {
        const int pm = u.pm; const bool lat = pm < 64; const int mb = lat ? (pm >> 5) : 2;
        const float* g = gate + mb * 9216;
        const float* brow = lat ? base_lat + (size_t)pm * 256 * 1024 : base_ctx + (size_t)(pm - 64) * 256 * 1024;
        float* orow = out + (size_t)pm * 256 * 1024;
        const int rl = wr * 64 + fr, col0 = u.pn * BM + wc * 32 + 4 * fq;
        f32x4 gv[2][2];
#pragma unroll
        for (int bj = 0; bj < 2; ++bj)
#pragma unroll
            for (int n = 0; n < 2; ++n) gv[bj][n] = *(const f32x4*)(g + col0 + bj * HALF + n * 16) * coef;
#pragma unroll
        for (int ai = 0; ai < 2; ++ai)
#pragma unroll
            for (int m = 0; m < 4; ++m) { const size_t off = (size_t)(rl + ai * HALF + m * 16) * 1024 + col0;
#pragma unroll
                for (int bj = 0; bj < 2; ++bj)
#pragma unroll
                    for (int n = 0; n < 2; ++n) { const f32x4 b = *(const f32x4*)(brow + off + bj * HALF + n * 16); *(f32x4*)(orow + off + bj * HALF + n * 16) = b + gv[bj][n] * acc[ai][bj][m][n]; }
                asm volatile("" ::: "memory"); }
    }
};
struct EpiQKVF {
    static constexpr bool PERM = false, AFTER_DRAIN = false;
    bf16_t *Q, *K, *V, *F; const cs2_t* rope;
    __device__ __forceinline__ void operator()(const f32x4 (&acc)[2][2][4][2], const Unit& u, int wr, int wc, int fr, int fq) const {
        const int pm = u.pm, pn = u.pn; const bool lat = pm < 64; const int type = pn < 4 ? 0 : (pn < 8 ? 1 : (pn < 12 ? 2 : 3));
        const float C2 = 0.125f * 1.4426950408889634f;
#pragma unroll
        for (int ai = 0; ai < 2; ++ai)
#pragma unroll
            for (int m = 0; m < 4; ++m) {
                const int row = pm * BM + ai * HALF + wr * 64 + m * 16 + fr;
                int kvrow, t;
                if (lat) { t = row & 8191; kvrow = (row >> 13) * 8448 + 256 + t; } else { const int r2 = row - LATROWS; t = r2 & 255; kvrow = (r2 >> 8) * 8448 + t; }
                const int pos = (wc & 1) ? (t & 63) : (t >> 6);
#pragma unroll
                for (int bj = 0; bj < 2; ++bj) {
                    f32x4 v0 = acc[ai][bj][m][0], v1 = acc[ai][bj][m][1];
                    if (type <= 1 && lat) {
#pragma unroll
                        for (int j = 0; j < 4; ++j) { const cs2_t cs = rope[pos * 16 + 4 * fq + j]; const float x1 = v0[j], x2 = v1[j]; v0[j] = x1 * cs.x - x2 * cs.y; v1[j] = x2 * cs.x + x1 * cs.y; }
                    }
                    const int col = (pn & 3) * BM + bj * HALF + wc * 32 + 4 * fq;
                    bf16_t* d;
                    if (type == 0) { v0 = v0 * C2; v1 = v1 * C2; d = Q + (size_t)row * 1024 + col; }
                    else if (type == 1) d = K + (size_t)kvrow * 1024 + col;
                    else if (type == 2) d = V + (size_t)kvrow * 1024 + col;
                    else d = F + (size_t)row * 512 + col;
                    u32x2 w0, w1; w0.x = cvt_pk_bf16(v0[0], v0[1]); w0.y = cvt_pk_bf16(v0[2], v0[3]); w1.x = cvt_pk_bf16(v1[0], v1[1]); w1.y = cvt_pk_bf16(v1[2], v1[3]);
                    *(u32x2*)d = w0; *(u32x2*)(d + 16) = w1;
                }
            }
    }
};
struct EpiGates {
    static constexpr bool PERM = true, AFTER_DRAIN = false;
    bf16_t* G; const float* bias;
    __device__ __forceinline__ void operator()(const f32x4 (&acc)[2][2][4][2], const Unit& u, int wr, int wc, int fr, int fq) const {
        const int row0 = u.pm * BM + wr * 64 + fr, col0 = u.pn * BM + wc * 32 + 8 * fq;
#pragma unroll
        for (int bj = 0; bj < 2; ++bj) {
            const f32x4 b0 = *(const f32x4*)(bias + col0 + bj * HALF), b1 = *(const f32x4*)(bias + col0 + bj * HALF + 4);
#pragma unroll
            for (int ai = 0; ai < 2; ++ai)
#pragma unroll
                for (int m = 0; m < 4; ++m) {
                    const f32x4 v0 = acc[ai][bj][m][0] + b0, v1 = acc[ai][bj][m][1] + b1;
                    u32x4 w; w.x = cvt_pk_bf16(sigm(v0[0]), sigm(v0[1])); w.y = cvt_pk_bf16(sigm(v0[2]), sigm(v0[3])); w.z = cvt_pk_bf16(sigm(v1[0]), sigm(v1[1])); w.w = cvt_pk_bf16(sigm(v1[2]), sigm(v1[3]));
                    *(u32x4*)(G + (size_t)(row0 + ai * HALF + m * 16) * 2048 + col0 + bj * HALF) = w;
                }
        }
    }
};
template <bool ADD> struct EpiGateMul {
    static constexpr bool PERM = true, AFTER_DRAIN = false;
    const bf16_t* G; bf16_t* MG; int goff;
    __device__ __forceinline__ void operator()(const f32x4 (&acc)[2][2][4][2], const Unit& u, int wr, int wc, int fr, int fq) const {
        const int row0 = u.pm * BM + wr * 64 + fr, col0 = u.pn * BM + wc * 32 + 8 * fq;
#pragma unroll
        for (int ai = 0; ai < 2; ++ai)
#pragma unroll
            for (int m = 0; m < 4; ++m)
#pragma unroll
                for (int bj = 0; bj < 2; ++bj) {
                    const size_t r = (size_t)(row0 + ai * HALF + m * 16); const int c = col0 + bj * HALF;
                    const u32x4 gw = *(const u32x4*)(G + r * 2048 + goff + c);
                    float o[8];
#pragma unroll
                    for (int j = 0; j < 4; ++j) { const unsigned gg = gw[j];
                        const float a0 = (j < 2) ? acc[ai][bj][m][0][2 * j] : acc[ai][bj][m][1][2 * j - 4], a1 = (j < 2) ? acc[ai][bj][m][0][2 * j + 1] : acc[ai][bj][m][1][2 * j - 3];
                        o[2 * j] = __builtin_bit_cast(float, gg << 16) * a0; o[2 * j + 1] = __builtin_bit_cast(float, gg & 0xffff0000u) * a1; }
                    bf16_t* p = MG + r * 1024 + c;
                    if (ADD) { const u32x4 pw = *(const u32x4*)p;
#pragma unroll
                        for (int j = 0; j < 4; ++j) { o[2 * j] += __builtin_bit_cast(float, pw[j] << 16); o[2 * j + 1] += __builtin_bit_cast(float, pw[j] & 0xffff0000u); } }
                    u32x4 w; w.x = cvt_pk_bf16(o[0], o[1]); w.y = cvt_pk_bf16(o[2], o[3]); w.z = cvt_pk_bf16(o[4], o[5]); w.w = cvt_pk_bf16(o[6], o[7]);
                    *(u32x4*)p = w;
                }
    }
};
struct EpiChanDFT {
    static constexpr bool PERM = false, AFTER_DRAIN = false;
    bf16_t* Z;
    __device__ __forceinline__ void operator()(const f32x4 (&acc)[2][2][4][2], const Unit& u, int wr, int wc, int fr, int fq) const {
        const int pm = u.pm; const bool lat = pm < 64;
#pragma unroll
        for (int ai = 0; ai < 2; ++ai)
#pragma unroll
            for (int m = 0; m < 4; ++m) {
                const int row = pm * BM + ai * HALF + wr * 64 + m * 16 + fr;
#pragma unroll
                for (int bj = 0; bj < 2; ++bj)
#pragma unroll
                    for (int n = 0; n < 2; ++n) {
                        const int chunk = u.pn * 64 + bj * 32 + wc * 8 + n * 4 + fq;
                        size_t off;
                        if (lat) off = ((size_t)((row >> 13) * 256 + chunk) * 8192 + (row & 8191)) * 4;
                        else { const int r2 = row - LATROWS; off = (size_t)LATROWS * 1024 + ((size_t)((r2 >> 8) * 256 + chunk) * 256 + (r2 & 255)) * 4; }
                        const f32x4 v = acc[ai][bj][m][n]; u32x2 w; w.x = cvt_pk_bf16(v[0], v[1]); w.y = cvt_pk_bf16(v[2], v[3]);
                        *(u32x2*)(Z + off) = w;
                    }
            }
    }
};

struct RmsExchange {
    unsigned* slots;
    unsigned* cnt;
    __device__ __forceinline__ void run(const f32x4 (&v)[2][2][4][2], const Unit& u, int wr, int wc, int fr, int fq, PG8_LAS unsigned char* lds, int wid, int lane) const {
        PG8_LAS float* P = (PG8_LAS float*)lds;
        PG8_LAS float* S = (PG8_LAS float*)(lds + 16384);
#pragma unroll
        for (int ai = 0; ai < 2; ++ai)
#pragma unroll
            for (int m = 0; m < 4; ++m) { float s = 0.f;
#pragma unroll
                for (int bj = 0; bj < 2; ++bj)
#pragma unroll
                    for (int n = 0; n < 2; ++n) { const f32x4 x = v[ai][bj][m][n]; s += (x[0] * x[0] + x[1] * x[1]) + (x[2] * x[2] + x[3] * x[3]); }
                P[(ai * HALF + wr * 64 + m * 16 + fr) * 16 + wc * 4 + fq] = s; }
        asm volatile("s_waitcnt lgkmcnt(0)" ::: "memory"); __builtin_amdgcn_s_barrier(); asm volatile("" ::: "memory");
        const int row = wid * 32 + (lane & 31);
        if (lane < 32) { float t = 0.f;
#pragma unroll
            for (int k = 0; k < 16; ++k) t += P[row * 16 + k];
            __hip_atomic_store(slots + (size_t)(u.pm * BM + row) * 4 + u.pn, __builtin_bit_cast(unsigned, t), __ATOMIC_RELAXED, __HIP_MEMORY_SCOPE_AGENT); }
        asm volatile("s_waitcnt vmcnt(0)" ::: "memory");
        if (lane == 0) __hip_atomic_fetch_add(cnt + 64 * u.pm, 1u, __ATOMIC_RELAXED, __HIP_MEMORY_SCOPE_AGENT);
        if (wid == 0) { unsigned sp = 0;
            while ((unsigned)__builtin_amdgcn_readfirstlane(__hip_atomic_load(cnt + 64 * u.pm, __ATOMIC_RELAXED, __HIP_MEMORY_SCOPE_AGENT)) < 32u) { __builtin_amdgcn_s_sleep(2); if (++sp > (1u << 22)) break; }
            __builtin_amdgcn_fence(__ATOMIC_ACQUIRE, "agent"); }
        asm volatile("s_waitcnt vmcnt(0) lgkmcnt(0)" ::: "memory"); __builtin_amdgcn_s_barrier(); asm volatile("" ::: "memory");
        if (lane < 32) { const unsigned* sl = slots + (size_t)(u.pm * BM + row) * 4; float t = 0.f;
#pragma unroll
            for (int k = 0; k < 4; ++k) t += __builtin_bit_cast(float, __hip_atomic_load(sl + k, __ATOMIC_RELAXED, __HIP_MEMORY_SCOPE_AGENT));
            S[row] = 1.0f / sqrtf(t * (1.0f / 1024.0f) + 1e-6f); }
        asm volatile("s_waitcnt lgkmcnt(0)" ::: "memory"); __builtin_amdgcn_s_barrier(); asm volatile("" ::: "memory");
    }
};
template <bool FINAL> struct EpiResidNorm {
    static constexpr bool PERM = false, AFTER_DRAIN = true;
    const float* base; float* X; const float* gate; float coef; const float* g; const float* mod; bf16_t* U; float* out; RmsExchange ex;
    __device__ __forceinline__ void fused(f32x4 (&acc)[2][2][4][2], const Unit& u, int wr, int wc, int fr, int fq, PG8_LAS unsigned char* lds, int wid, int lane) const {
        const int pm = u.pm, mb = pm >> 5; const float* gt = gate + mb * 9216;
        const int rl = wr * 64 + fr, col0 = u.pn * BM + wc * 32 + 4 * fq; const size_t rbase = (size_t)pm * 256 * 1024;
#pragma unroll
        for (int bj = 0; bj < 2; ++bj)
#pragma unroll
            for (int n = 0; n < 2; ++n) { const int col = col0 + bj * HALF + n * 16; const f32x4 gv = *(const f32x4*)(gt + col) * coef;
#pragma unroll
                for (int ai = 0; ai < 2; ++ai)
#pragma unroll
                    for (int m = 0; m < 4; ++m) { const size_t off = rbase + (size_t)(rl + ai * HALF + m * 16) * 1024 + col;
                        const f32x4 xn = *(const f32x4*)(base + off) + gv * acc[ai][bj][m][n]; acc[ai][bj][m][n] = xn; if (!FINAL) *(f32x4*)(X + off) = xn; }
                asm volatile("" ::: "memory"); }
        ex.run(acc, u, wr, wc, fr, fq, lds, wid, lane);
        const PG8_LAS float* S = (const PG8_LAS float*)(lds + 16384);
#pragma unroll
        for (int bj = 0; bj < 2; ++bj)
#pragma unroll
            for (int n = 0; n < 2; ++n) { const int col = col0 + bj * HALF + n * 16; const f32x4 gg = *(const f32x4*)(g + col);
                f32x4 sc, sh; if (!FINAL) { sh = *(const f32x4*)(mod + mb * 9216 + col); sc = *(const f32x4*)(mod + mb * 9216 + 1024 + col) + 1.0f; }
#pragma unroll
                for (int ai = 0; ai < 2; ++ai)
#pragma unroll
                    for (int m = 0; m < 4; ++m) { const int r = rl + ai * HALF + m * 16; const size_t off = rbase + (size_t)r * 1024 + col; const f32x4 y = acc[ai][bj][m][n] * S[r] * gg;
                        if (FINAL) *(f32x4*)(out + off) = y;
                        else { const f32x4 o = y * sc + sh; u32x2 w; w.x = cvt_pk_bf16(o[0], o[1]); w.y = cvt_pk_bf16(o[2], o[3]); *(u32x2*)(U + off) = w; } }
                asm volatile("" ::: "memory"); }
    }
};
template <class Epi, class Sched, bool ALIGN_EPI = false, bool SP2 = false>
__device__ __forceinline__ void gemm_phase(PG8_LAS unsigned char* lds, const Gemm g, const Sched& S, const Epi& E) {
    int tid = threadIdx.x; asm volatile("" : "+v"(tid));
    const int wid = __builtin_amdgcn_readfirstlane(tid >> 6), lane = tid & 63, wr = wid >> 2, wc = wid & 3, fr = lane & 15, fq = lane >> 4;
    const int K = g.K, nt = K / BK;
    unsigned voffA[2], voffB[2];
#pragma unroll
    for (int i = 0; i < 2; ++i) { int R, C; stage_rc(tid * 16 + i * 8192, R, C); const int Rb = Epi::PERM ? ((R & ~31) + perm32(R & 31)) : R;
        voffA[i] = (unsigned)(R * K + C) * 2u; voffB[i] = (unsigned)(Rb * K + C) * 2u; }
    const size_t kstep = (size_t)(BK * 2);
    const size_t hstep = (size_t)HALF * K * 2;
    const size_t tstep = 2 * hstep;
    const unsigned ldsw = (unsigned)wid * 1024u;
    const int aoff = lds_byte(wr * 64 + fr, fq * 8), boff = lds_byte(wc * 32 + fr, fq * 8);
#define PG8_SA(b, h) (((b) * 2 + (h)) * HTB)
#define PG8_SB(b, h) ((4 + (b) * 2 + (h)) * HTB)
#define PG8_STAGE(bufoff, gbase, voff) do { _Pragma("unroll") for (int _i = 0; _i < 2; ++_i) \
        __builtin_amdgcn_global_load_lds((const unsigned*)((const char*)(gbase) + (voff)[_i]), (PG8_LAS unsigned*)(lds + (bufoff) + ldsw + _i * 8192), 16, 0, 0); } while (0)
#define PG8_LDA(dst, b, h) do { _Pragma("unroll") for (int m = 0; m < 4; ++m) _Pragma("unroll") for (int k = 0; k < 2; ++k) dst[m][k] = *(const PG8_LAS bf16x8*)(lds + PG8_SA(b, h) + aoff + m * 2048 + k * 1024); } while (0)
#define PG8_LDB(dst, b, h) do { _Pragma("unroll") for (int n = 0; n < 2; ++n) _Pragma("unroll") for (int k = 0; k < 2; ++k) dst[n][k] = *(const PG8_LAS bf16x8*)(lds + PG8_SB(b, h) + boff + n * 2048 + k * 1024); } while (0)
#define PG8_MMA(ai, bj, At, Bt) do { __builtin_amdgcn_s_setprio(1); _Pragma("unroll") for (int m = 0; m < 4; ++m) _Pragma("unroll") for (int n = 0; n < 2; ++n) _Pragma("unroll") for (int k = 0; k < 2; ++k) \
        acc[ai][bj][m][n] = __builtin_amdgcn_mfma_f32_16x16x32_bf16(Bt[n][k], At[m][k], acc[ai][bj][m][n], 0, 0, 0); __builtin_amdgcn_s_setprio(0); } while (0)
#define PG8_WAIT_V(n) asm volatile("s_waitcnt vmcnt(" #n ")" ::: "memory")
#define PG8_WAIT_L(n) asm volatile("s_waitcnt lgkmcnt(" #n ")" ::: "memory")
#define PG8_BAR __builtin_amdgcn_s_barrier()
#define PG8_SCHED __builtin_amdgcn_sched_barrier(0)
    Unit cur, nxt; int ui = 0;
    if (!S.next(0, cur)) return;
    f32x4 acc[2][2][4][2];
#pragma unroll
    for (int a = 0; a < 2; ++a)
#pragma unroll
        for (int b = 0; b < 2; ++b)
#pragma unroll
            for (int m = 0; m < 4; ++m)
#pragma unroll
                for (int n = 0; n < 2; ++n) acc[a][b][m][n] = (f32x4){0.f, 0.f, 0.f, 0.f};
    bf16x8 At[4][2], B0[2][2], B1[2][2];
    const char* cA = (const char*)g.A + (size_t)cur.pm * tstep; const char* cB = (const char*)g.Bt + (size_t)cur.pn * tstep;
    S.a_ready(cur);
    if constexpr (SP2) {
        PG8_STAGE(PG8_SB(0, 0), cB, voffB); PG8_STAGE(PG8_SB(0, 1), cB + hstep, voffB); PG8_STAGE(PG8_SA(0, 0), cA, voffA); PG8_STAGE(PG8_SA(0, 1), cA + hstep, voffA);
        if (wr == 1) PG8_BAR;
        PG8_WAIT_V(2); PG8_BAR;
        PG8_STAGE(PG8_SB(1, 0), cB + kstep, voffB); PG8_STAGE(PG8_SA(1, 0), cA + kstep, voffA); PG8_STAGE(PG8_SB(1, 1), cB + hstep + kstep, voffB);
        PG8_WAIT_V(6); PG8_BAR;
    } else {
        PG8_STAGE(PG8_SB(0, 0), cB, voffB); PG8_STAGE(PG8_SA(0, 0), cA, voffA); PG8_STAGE(PG8_SB(0, 1), cB + hstep, voffB); PG8_STAGE(PG8_SA(0, 1), cA + hstep, voffA);
        if (wr == 1) PG8_BAR;
        PG8_WAIT_V(4); PG8_BAR;
        PG8_STAGE(PG8_SB(1, 0), cB + kstep, voffB); PG8_STAGE(PG8_SA(1, 0), cA + kstep, voffA); PG8_STAGE(PG8_SB(1, 1), cB + hstep + kstep, voffB);
        PG8_WAIT_V(6); PG8_BAR;
    }
    for (;;) {
        const bool has_next = S.next(ui + 1, nxt);
        const char* nA = has_next ? (const char*)g.A + (size_t)nxt.pm * tstep : cA; const char* nB = has_next ? (const char*)g.Bt + (size_t)nxt.pn * tstep : cB;
        for (int t = 0; t < nt; t += 2) {
            const bool last = (t == nt - 2);
            const char* a1 = cA + (size_t)(t + 1) * kstep;
            const char* a2 = last ? nA : cA + (size_t)(t + 2) * kstep; const char* b2 = last ? nB : cB + (size_t)(t + 2) * kstep;
            const char* a3 = a2 + kstep; const char* b3 = b2 + kstep;
            if (last && has_next) S.a_ready(nxt);
            if constexpr (SP2) {
            PG8_LDB(B0, 0, 0); PG8_LDB(B1, 0, 1); PG8_SCHED; PG8_LDA(At, 0, 0); PG8_STAGE(PG8_SA(1, 1), a1 + hstep, voffA);
            PG8_WAIT_V(8); PG8_WAIT_L(0); PG8_BAR; PG8_MMA(0, 0, At, B0); PG8_MMA(0, 1, At, B1); PG8_BAR; PG8_SCHED;
            PG8_LDA(At, 0, 1); PG8_STAGE(PG8_SB(0, 0), b2, voffB); PG8_STAGE(PG8_SB(0, 1), b2 + hstep, voffB); PG8_STAGE(PG8_SA(0, 0), a2, voffA);
            PG8_WAIT_V(8); PG8_WAIT_L(0); PG8_BAR; PG8_MMA(1, 0, At, B0); PG8_MMA(1, 1, At, B1); PG8_BAR; PG8_SCHED;
            PG8_LDB(B0, 1, 0); PG8_LDB(B1, 1, 1); PG8_SCHED; PG8_LDA(At, 1, 0); PG8_STAGE(PG8_SA(0, 1), a2 + hstep, voffA);
            PG8_WAIT_V(8); PG8_WAIT_L(0); PG8_BAR; PG8_MMA(0, 0, At, B0); PG8_MMA(0, 1, At, B1); PG8_BAR; PG8_SCHED;
            PG8_LDA(At, 1, 1); PG8_STAGE(PG8_SB(1, 0), b3, voffB); PG8_STAGE(PG8_SB(1, 1), b3 + hstep, voffB); PG8_STAGE(PG8_SA(1, 0), a3, voffA);
            PG8_WAIT_V(8); PG8_WAIT_L(0); PG8_BAR; PG8_MMA(1, 0, At, B0); PG8_MMA(1, 1, At, B1); PG8_BAR; PG8_SCHED;
            } else {
            PG8_LDB(B0, 0, 0); PG8_SCHED; PG8_LDA(At, 0, 0); PG8_STAGE(PG8_SA(1, 1), a1 + hstep, voffA);
            PG8_WAIT_L(8); PG8_BAR; PG8_WAIT_L(0); PG8_MMA(0, 0, At, B0); PG8_BAR; PG8_SCHED;
            PG8_LDB(B1, 0, 1); PG8_STAGE(PG8_SB(0, 0), b2, voffB);
            PG8_BAR; PG8_WAIT_L(0); PG8_MMA(0, 1, At, B1); PG8_BAR;
            PG8_LDA(At, 0, 1); PG8_STAGE(PG8_SA(0, 0), a2, voffA);
            PG8_BAR; PG8_WAIT_L(0); PG8_MMA(1, 0, At, B0); PG8_BAR; PG8_SCHED;
            PG8_STAGE(PG8_SB(0, 1), b2 + hstep, voffB);
            PG8_WAIT_V(6); PG8_BAR; PG8_MMA(1, 1, At, B1); PG8_BAR;
            PG8_LDB(B0, 1, 0); PG8_SCHED; PG8_LDA(At, 1, 0); PG8_STAGE(PG8_SA(0, 1), a2 + hstep, voffA);
            PG8_WAIT_L(8); PG8_BAR; PG8_WAIT_L(0); PG8_MMA(0, 0, At, B0); PG8_BAR; PG8_SCHED;
            PG8_LDB(B1, 1, 1); PG8_STAGE(PG8_SB(1, 0), b3, voffB);
            PG8_BAR; PG8_WAIT_L(0); PG8_MMA(0, 1, At, B1); PG8_BAR;
            PG8_LDA(At, 1, 1); PG8_STAGE(PG8_SA(1, 0), a3, voffA);
            PG8_BAR; PG8_WAIT_L(0); PG8_MMA(1, 0, At, B0); PG8_BAR; PG8_SCHED;
            PG8_STAGE(PG8_SB(1, 1), b3 + hstep, voffB);
            PG8_WAIT_V(6); PG8_BAR; PG8_MMA(1, 1, At, B1); PG8_BAR;
            }
        }
        if constexpr (ALIGN_EPI) { if (wr == 0) PG8_BAR; }
        if constexpr (!Epi::AFTER_DRAIN) { E(acc, cur, wr, wc, fr, fq); S.done(cur); }
        if (!has_next) break;
#pragma unroll
        for (int a = 0; a < 2; ++a)
#pragma unroll
            for (int b = 0; b < 2; ++b)
#pragma unroll
                for (int m = 0; m < 4; ++m)
#pragma unroll
                    for (int n = 0; n < 2; ++n) acc[a][b][m][n] = (f32x4){0.f, 0.f, 0.f, 0.f};
        cur = nxt; cA = nA; cB = nB; ++ui;
        if constexpr (ALIGN_EPI) { if (wr == 1) PG8_BAR; }
    }
    PG8_WAIT_V(0);
    if constexpr (!ALIGN_EPI) { if (wr == 0) PG8_BAR; }
    PG8_BAR;
    if constexpr (Epi::AFTER_DRAIN) { E.fused(acc, cur, wr, wc, fr, fq, lds, wid, lane); S.done(cur); }
#undef PG8_SA
#undef PG8_SB
#undef PG8_STAGE
#undef PG8_LDA
#undef PG8_LDB
#undef PG8_MMA
#undef PG8_WAIT_V
#undef PG8_WAIT_L
#undef PG8_BAR
#undef PG8_SCHED
}
}
#include <hip/hip_bf16.h>
#include <cmath>
namespace attn_body {
using bf16=__hip_bfloat16;
using bf16x8=__attribute__((ext_vector_type(8)))short;
using s16x4=__attribute__((ext_vector_type(4)))short;
using f32x16=__attribute__((ext_vector_type(16)))float;
using u32x4=__attribute__((ext_vector_type(4)))unsigned;
constexpr int D=64,DM=1024;
constexpr int NW=8,QBLK=32,QB=QBLK*NW,KVBLK=64;
constexpr int ATTN_PITCH=DM, ATTN_UNIT_ROWS=QB;
__device__ __forceinline__ int crow(int r,int hi){return (r&3)+8*(r>>2)+4*hi;}
#define SBAR() __builtin_amdgcn_sched_barrier(0)
__device__ __forceinline__ void cmask(f32x16&p0,f32x16&p1,int jb,int qrel,int hi){
  const float NEG=-INFINITY; int kb=64*jb+4*hi;
  #pragma unroll
  for(int r=0;r<16;++r){int kv=kb+(r&3)+8*(r>>2); if(kv>qrel)p0[r]=NEG; if(kv+32>qrel)p1[r]=NEG;}
}

constexpr int NSLOT=3, SLOTB=8192;
constexpr int LDS_K=0, LDS_V=NSLOT*SLOTB, LDS_WS=3*NSLOT*SLOTB, LDS_OST=LDS_WS+NW*64*4, LDS_BYTES=LDS_OST+NW*4096;
constexpr float C2=0.125f*1.4426950408889634f;
__device__ __forceinline__ void glds16(const void*gsrc,unsigned lds_dst){unsigned keep;
  asm volatile("s_mov_b32 %0, m0\n\ts_mov_b32 m0, %2\n\ts_nop 0\n\tglobal_load_lds_dwordx4 %1, off\n\ts_mov_b32 m0, %0":"=&s"(keep):"v"(gsrc),"s"(lds_dst):"memory");}
__device__ __forceinline__ float max3f(float a,float b,float c){float r;asm("v_max3_f32 %0, %1, %2, %3":"=v"(r):"v"(a),"v"(b),"v"(c));return r;}
__device__ __forceinline__ float max2f(float a,float b){float r;asm("v_max_f32_e32 %0, %1, %2":"=v"(r):"v"(a),"v"(b));return r;}
__device__ __forceinline__ float fadd_s(float a,float b){float r;asm("v_add_f32_e32 %0, %1, %2":"=v"(r):"v"(a),"v"(b));return r;}
__device__ __forceinline__ float fsub_s(float a,float b){float r;asm("v_sub_f32_e32 %0, %1, %2":"=v"(r):"v"(a),"v"(b));return r;}
typedef float f32x2_t __attribute__((ext_vector_type(2))); typedef __bf16 bf16x2_t __attribute__((ext_vector_type(2)));
__device__ __forceinline__ unsigned cvtpk_s(float lo,float hi){f32x2_t v={lo,hi};bf16x2_t b=__builtin_convertvector(v,bf16x2_t);return __builtin_bit_cast(unsigned,b);}
#define WAIT_BAR(N) asm volatile("s_waitcnt vmcnt(" #N ") lgkmcnt(0)\n\ts_barrier":::"memory")

__device__ __forceinline__ void qkt(f32x16&p0,f32x16&p1,const char*Kslot,const bf16x8*qr,const f32x16&negm,int r32,int hi){
  const char*kb=Kslot+hi*1024+r32*16;
  #pragma unroll
  for(int d0=0;d0<4;++d0){
    const bf16x8 b0=*reinterpret_cast<const bf16x8*>(kb+d0*2048);
    const bf16x8 b1=*reinterpret_cast<const bf16x8*>(kb+d0*2048+512);
    if(d0==0){p0=__builtin_amdgcn_mfma_f32_32x32x16_bf16(b0,qr[0],negm,0,0,0);p1=__builtin_amdgcn_mfma_f32_32x32x16_bf16(b1,qr[0],negm,0,0,0);}
    else{p0=__builtin_amdgcn_mfma_f32_32x32x16_bf16(b0,qr[d0],p0,0,0,0);p1=__builtin_amdgcn_mfma_f32_32x32x16_bf16(b1,qr[d0],p1,0,0,0);}}
}
typedef __attribute__((address_space(3))) const char* lds_cptr;
typedef short v4i16_t __attribute__((ext_vector_type(4)));
__device__ __forceinline__ void kload8(bf16x8*kf,lds_cptr kp){
  kf[0]=*(const __attribute__((address_space(3))) bf16x8*)(kp);      kf[1]=*(const __attribute__((address_space(3))) bf16x8*)(kp+512);
  kf[2]=*(const __attribute__((address_space(3))) bf16x8*)(kp+2048); kf[3]=*(const __attribute__((address_space(3))) bf16x8*)(kp+2560);
  kf[4]=*(const __attribute__((address_space(3))) bf16x8*)(kp+4096); kf[5]=*(const __attribute__((address_space(3))) bf16x8*)(kp+4608);
  kf[6]=*(const __attribute__((address_space(3))) bf16x8*)(kp+6144); kf[7]=*(const __attribute__((address_space(3))) bf16x8*)(kp+6656);
}
__device__ __forceinline__ void kload2(bf16x8*kf,lds_cptr kp,int j){ kf[2*j]=*(const __attribute__((address_space(3))) bf16x8*)(kp+j*2048); kf[2*j+1]=*(const __attribute__((address_space(3))) bf16x8*)(kp+j*2048+512); }
__device__ __forceinline__ s16x4 vtr(lds_cptr p){ return __builtin_bit_cast(s16x4,__builtin_amdgcn_ds_read_tr16_b64_v4i16((__attribute__((address_space(3))) v4i16_t*)p)); }
__device__ __forceinline__ float rowmax(const f32x16&p0,const f32x16&p1){
  float a=max3f(p0[0],p0[1],p1[0]),b=max3f(p0[2],p0[3],p1[1]);a=max3f(a,p1[2],p1[3]);
  #pragma unroll
  for(int r=4;r<16;r+=4){a=max3f(a,p0[r],p0[r+1]);b=max3f(b,p0[r+2],p0[r+3]);a=max3f(a,p1[r],p1[r+1]);b=max3f(b,p1[r+2],p1[r+3]);}
  const float m=max2f(a,b);
  auto rr=__builtin_amdgcn_permlane32_swap(__float_as_uint(m),__float_as_uint(m),false,false);
  return max2f(__uint_as_float(rr[0]),__uint_as_float(rr[1]));
}
__device__ __forceinline__ void pv(f32x16*o,int vb,bf16x8 pa0,bf16x8 pa1,bf16x8 pa2,bf16x8 pa3){
  #pragma unroll
  for(int d0=0;d0<2;++d0){s16x4 lo[4],hi[4];
    #pragma unroll
    for(int ks=0;ks<4;++ks){
      asm volatile("ds_read_b64_tr_b16 %0,%1 offset:%c2":"=&v"(lo[ks]):"v"(vb),"i"(d0*4096+ks*1024):"memory");
      asm volatile("ds_read_b64_tr_b16 %0,%1 offset:%c2":"=&v"(hi[ks]):"v"(vb),"i"(d0*4096+ks*1024+512):"memory");}
    asm volatile("s_waitcnt lgkmcnt(0)":::"memory");SBAR();
    #define PK(k) (bf16x8){lo[k][0],lo[k][1],lo[k][2],lo[k][3],hi[k][0],hi[k][1],hi[k][2],hi[k][3]}
    o[d0]=__builtin_amdgcn_mfma_f32_32x32x16_bf16(pa0,PK(0),o[d0],0,0,0);
    o[d0]=__builtin_amdgcn_mfma_f32_32x32x16_bf16(pa1,PK(1),o[d0],0,0,0);
    o[d0]=__builtin_amdgcn_mfma_f32_32x32x16_bf16(pa2,PK(2),o[d0],0,0,0);
    o[d0]=__builtin_amdgcn_mfma_f32_32x32x16_bf16(pa3,PK(3),o[d0],0,0,0);
    #undef PK
  }
}

#ifndef ATTN_STORE16
#define ATTN_STORE16(p,v) (*(u32x4*)(p)=(v))
#endif
template<int THRL> __device__ __forceinline__ void attn_unit(const bf16*Qu,const bf16*__restrict__ Kh,const bf16*__restrict__ Vh,bf16*Ou,const int NT,char*shm){
  int tid=threadIdx.x; asm volatile("":"+v"(tid)); const int lane=tid&63,r32=lane&31,hi=lane>>5; const int wid=__builtin_amdgcn_readfirstlane(tid>>6);
  const bf16*Qw=Qu+(long)(wid*QBLK)*DM;
  const unsigned lds0=(unsigned)(uintptr_t)shm;
  float*wsf=(float*)(shm+LDS_WS)+wid*64;
  const bf16*ksrc=Kh+(long)lane*DM+wid*8;
  const bf16*vsrc=Vh+(long)(16*(wid&3)+(lane>>2))*DM+(wid>>2)*32+(lane&3)*8;
  const unsigned kdst=lds0+LDS_K+wid*1024, vdst=lds0+LDS_V+wid*1024;
  #define DMA_K(t,slot) glds16(ksrc+(long)(t)*KVBLK*DM,(unsigned)__builtin_amdgcn_readfirstlane(kdst+(slot)))
  #define DMA_V(t,slot) do{ glds16(vsrc+(long)(t)*KVBLK*DM,(unsigned)__builtin_amdgcn_readfirstlane(vdst+2*(slot))); glds16(vsrc+64+(long)(t)*KVBLK*DM,(unsigned)__builtin_amdgcn_readfirstlane(vdst+2*(slot)+SLOTB)); }while(0)
  const int vb0=(int)(lds0+LDS_V)+((lane>>4)&1)*32+(lane&3)*8+(4*hi+((lane&15)>>2))*64;
  const char*Kbase=shm+LDS_K; bf16x8 kf[8];
  const lds_cptr shm3=(lds_cptr)shm; const lds_cptr kp0=shm3+LDS_K+hi*1024+r32*16; const lds_cptr vp0=shm3+LDS_V+((lane>>4)&1)*32+(lane&3)*8+(4*hi+((lane&15)>>2))*64;
  DMA_K(0,0);DMA_V(0,0);DMA_K(1,SLOTB);
  bf16x8 qr[4];
  #pragma unroll
  for(int d0=0;d0<4;++d0)qr[d0]=*reinterpret_cast<const bf16x8*>(&Qw[(long)r32*DM+d0*16+hi*8]);
  float mhat=0.f,l_reg=0.f;f32x16 o[4];o[0]=f32x16{};o[1]=f32x16{};o[2]=f32x16{};o[3]=f32x16{};const f32x16 z16=f32x16{};
  #define CMASK(P0,P1,t) do{}while(0)
  bool resc=false;
  #define START(P0,P1) do{ const float rm=rowmax(P0,P1); resc=false; \
    { const float dl=rm; mhat=fadd_s(mhat,dl); \
      _Pragma("unroll") for(int r=0;r<16;++r){P0[r]=fsub_s(P0[r],dl);P1[r]=fsub_s(P1[r],dl);} \
      } \
    _Pragma("unroll") for(int r=0;r<16;++r)P0[r]=__builtin_amdgcn_exp2f(P0[r]); }while(0)
  #define RESC() do{ if(resc){ asm volatile("s_waitcnt lgkmcnt(0)":::"memory"); \
      _Pragma("unroll") for(int d_=0;d_<4;++d_) _Pragma("unroll") for(int r=0;r<16;++r)o[d_][r]*=wsf[crow(r,hi)]; } }while(0)
  f32x16 pA0,pA1,pB0,pB1;
  int sl_prev=0,sl_cur=0,sl_next=SLOTB;
  #define ROT() do{sl_prev=sl_cur;sl_cur=sl_next;sl_next=(sl_next==(NSLOT-1)*SLOTB)?0:sl_next+SLOTB;}while(0)
  DMA_K(2,2*SLOTB);
  WAIT_BAR(4);
  qkt(pA0,pA1,Kbase,qr,z16,r32,hi);asm volatile("s_nop 15\n\ts_nop 7":"+v"(pA0),"+v"(pA1));CMASK(pA0,pA1,0);
  START(pA0,pA1);
  _Pragma("unroll") for(int r=0;r<16;++r)pA1[r]=__builtin_amdgcn_exp2f(pA1[r]);
  WAIT_BAR(0);
  DMA_K(3,0);DMA_V(1,SLOTB);
  ROT();
  kload8(kf,kp0+sl_cur);
  WAIT_BAR(3);
  s16x4 vlo[8],vhi[8]; u32x4 pw0,pw1,pw2,pw3;
  #define PKW(P,B) cvtpk_s(P[B],P[B+1])
  #define PAF(k) __builtin_bit_cast(bf16x8,pw##k)
  #define VFR(i) (bf16x8){vlo[i][0],vlo[i][1],vlo[i][2],vlo[i][3],vhi[i][0],vhi[i][1],vhi[i][2],vhi[i][3]}
  #define PIN(x) asm volatile("":"+v"(x))
  #define MX3(a,b,c) __builtin_fmaxf(__builtin_fmaxf((a),(b)),(c))
  #define GAPA(MF,A0,A1,A2,A3,W0,W1,PW) do{ MF; sacc+=A0; sacc+=A1; sacc+=A2; sacc+=A3; PIN(sacc); W0; W1; PIN(PW); SBAR(); }while(0)
  #define EX(v) __builtin_amdgcn_exp2f(v)
  #define GAPB(MF,X,B) do{ MF; X[B]=EX(X[B]); X[B+1]=EX(X[B+1]); X[B+2]=EX(X[B+2]); X[B+3]=EX(X[B+3]); PIN(X); SBAR(); }while(0)
  #define VRD(i) do{ vlo[i]=vtr(vp_+(((i)>>2)*4096+((i)&3)*1024)); vhi[i]=vtr(vp_+(((i)>>2)*4096+((i)&3)*1024+512)); }while(0)
  #define VRD2(i) do{ vlo[i]=vtr(vp_+(8192+((i)>>2)*4096+((i)&3)*1024)); vhi[i]=vtr(vp_+(8192+((i)>>2)*4096+((i)&3)*1024+512)); }while(0)
  #define KRD(G,j) do{ if(G){ kload2(kf,kp0+sl_next,j); SBAR(); } }while(0)
  #define STEP(C0,C1,P0,P1,t,GK,GV,GL) do{ SBAR(); \
    const lds_cptr vp_=vp0+2*sl_prev; \
    VRD(0); SBAR(); float sacc=(P0[0]+P0[1]); \
    GAPA(C0=__builtin_amdgcn_mfma_f32_32x32x16_bf16(kf[0],qr[0],z16,0,0,0), P0[2],P0[3],P0[4],P0[5],     pw0[0]=PKW(P0,0), pw0[1]=PKW(P0,2), pw0); \
    VRD(4); SBAR(); GAPA(C1=__builtin_amdgcn_mfma_f32_32x32x16_bf16(kf[1],qr[0],z16,0,0,0), P0[6],P0[7],P0[8],P0[9],     pw0[2]=PKW(P0,4), pw0[3]=PKW(P0,6), pw0); \
    VRD(1); SBAR(); GAPA(C0=__builtin_amdgcn_mfma_f32_32x32x16_bf16(kf[2],qr[1],C0,0,0,0),   P0[10],P0[11],P0[12],P0[13], pw1[0]=PKW(P0,8), pw1[1]=PKW(P0,10), pw1); \
    VRD(5); SBAR(); GAPA(C1=__builtin_amdgcn_mfma_f32_32x32x16_bf16(kf[3],qr[1],C1,0,0,0),   P0[14],P0[15],P1[0],P1[1],   pw1[2]=PKW(P0,12),pw1[3]=PKW(P0,14), pw1); \
    VRD(2); SBAR(); GAPA(C0=__builtin_amdgcn_mfma_f32_32x32x16_bf16(kf[4],qr[2],C0,0,0,0),   P1[2],P1[3],P1[4],P1[5],     pw2[0]=PKW(P1,0), pw2[1]=PKW(P1,2), pw2); \
    VRD(6); SBAR(); GAPA(C1=__builtin_amdgcn_mfma_f32_32x32x16_bf16(kf[5],qr[2],C1,0,0,0),   P1[6],P1[7],P1[8],P1[9],     pw2[2]=PKW(P1,4), pw2[3]=PKW(P1,6), pw2); \
    VRD(3); SBAR(); GAPA(C0=__builtin_amdgcn_mfma_f32_32x32x16_bf16(kf[6],qr[3],C0,0,0,0),   P1[10],P1[11],P1[12],P1[13], pw3[0]=PKW(P1,8), pw3[1]=PKW(P1,10), pw3); \
    VRD(7); SBAR(); GAPA(C1=__builtin_amdgcn_mfma_f32_32x32x16_bf16(kf[7],qr[3],C1,0,0,0),   P1[14],P1[15],0.f,0.f,       pw3[2]=PKW(P1,12),pw3[3]=PKW(P1,14), pw3); \
    l_reg+=sacc; \
    if(GK){DMA_K((t)+3,sl_cur);} if(GV){DMA_V((t)+1,sl_next);} \
    _Pragma("unroll") for(int r=0;r<16;++r){C0[r]-=mhat;C1[r]-=mhat;} \
    CMASK(C0,C1,t); \
    { float a=MX3(C0[0],C0[1],C1[0]),b=MX3(C0[2],C0[3],C1[1]); a=MX3(a,C1[2],C1[3]); \
      _Pragma("unroll") for(int r=4;r<16;r+=4){a=MX3(a,C0[r],C0[r+1]);b=MX3(b,C0[r+2],C0[r+3]);a=MX3(a,C1[r],C1[r+1]);b=MX3(b,C1[r+2],C1[r+3]);} \
      float rm=__builtin_fmaxf(a,b); { auto rr=__builtin_amdgcn_permlane32_swap(__float_as_uint(rm),__float_as_uint(rm),false,false); rm=__builtin_fmaxf(__uint_as_float(rr[0]),__uint_as_float(rr[1])); } \
      resc=false; \
      if(__builtin_expect(__any(rm>(float)THRL),0)){ const float dl=__builtin_fmaxf(rm,0.f); mhat+=dl; \
        _Pragma("unroll") for(int r=0;r<16;++r){C0[r]-=dl;C1[r]-=dl;} \
        const float f=__builtin_amdgcn_exp2f(-dl); l_reg*=f; if(hi==0)wsf[r32]=f; resc=true; } } \
    SBAR(); \
    GAPB(o[0]=__builtin_amdgcn_mfma_f32_32x32x16_bf16(PAF(0),VFR(0),o[0],0,0,0), C0,0); \
    GAPB(o[1]=__builtin_amdgcn_mfma_f32_32x32x16_bf16(PAF(0),VFR(4),o[1],0,0,0), C0,4); \
    KRD(GL,0); GAPB(o[0]=__builtin_amdgcn_mfma_f32_32x32x16_bf16(PAF(1),VFR(1),o[0],0,0,0), C0,8); \
    KRD(GL,1); GAPB(o[1]=__builtin_amdgcn_mfma_f32_32x32x16_bf16(PAF(1),VFR(5),o[1],0,0,0), C0,12); \
    KRD(GL,2); GAPB(o[0]=__builtin_amdgcn_mfma_f32_32x32x16_bf16(PAF(2),VFR(2),o[0],0,0,0), C1,0); \
    KRD(GL,3); GAPB(o[1]=__builtin_amdgcn_mfma_f32_32x32x16_bf16(PAF(2),VFR(6),o[1],0,0,0), C1,4); \
    GAPB(o[0]=__builtin_amdgcn_mfma_f32_32x32x16_bf16(PAF(3),VFR(3),o[0],0,0,0), C1,8); \
    GAPB(o[1]=__builtin_amdgcn_mfma_f32_32x32x16_bf16(PAF(3),VFR(7),o[1],0,0,0), C1,12); \
    VRD2(0); VRD2(4); VRD2(1); VRD2(5); SBAR(); \
    o[2]=__builtin_amdgcn_mfma_f32_32x32x16_bf16(PAF(0),VFR(0),o[2],0,0,0); o[3]=__builtin_amdgcn_mfma_f32_32x32x16_bf16(PAF(0),VFR(4),o[3],0,0,0); VRD2(2); VRD2(6); SBAR(); \
    o[2]=__builtin_amdgcn_mfma_f32_32x32x16_bf16(PAF(1),VFR(1),o[2],0,0,0); o[3]=__builtin_amdgcn_mfma_f32_32x32x16_bf16(PAF(1),VFR(5),o[3],0,0,0); VRD2(3); VRD2(7); SBAR(); \
    o[2]=__builtin_amdgcn_mfma_f32_32x32x16_bf16(PAF(2),VFR(2),o[2],0,0,0); o[3]=__builtin_amdgcn_mfma_f32_32x32x16_bf16(PAF(2),VFR(6),o[3],0,0,0); SBAR(); \
    o[2]=__builtin_amdgcn_mfma_f32_32x32x16_bf16(PAF(3),VFR(3),o[2],0,0,0); o[3]=__builtin_amdgcn_mfma_f32_32x32x16_bf16(PAF(3),VFR(7),o[3],0,0,0); SBAR(); \
    }while(0)
  int t=1;
  #undef CMASK
  #define CMASK(P0,P1,t) do{}while(0)
  for(;t+5<NT;t+=2){
    STEP(pB0,pB1,pA0,pA1,t,true,true,true);     WAIT_BAR(3); RESC(); ROT();
    STEP(pA0,pA1,pB0,pB1,t+1,true,true,true);   WAIT_BAR(3); RESC(); ROT();
  }
  #undef CMASK
  #define CMASK(P0,P1,t) do{}while(0)
  #define ENDW(tt) do{ if((tt)+3<NT){WAIT_BAR(3);} else if((tt)+2<NT){WAIT_BAR(2);} else {WAIT_BAR(0);} }while(0)
  for(;t+1<NT;t+=2){
    STEP(pB0,pB1,pA0,pA1,t,(t+3<NT),(t+1<NT),(t+1<NT));       ENDW(t);   RESC(); ROT();
    STEP(pA0,pA1,pB0,pB1,t+1,(t+4<NT),(t+2<NT),(t+2<NT));     ENDW(t+1); RESC(); ROT();
  }
  STEP(pB0,pB1,pA0,pA1,NT-1,false,false,false); RESC();
  { float sacc=pB0[0]+pB0[1]; _Pragma("unroll") for(int r=2;r<16;++r)sacc+=pB0[r]; _Pragma("unroll") for(int r=0;r<16;++r)sacc+=pB1[r]; l_reg+=sacc;
    pw0=(u32x4){PKW(pB0,0),PKW(pB0,2),PKW(pB0,4),PKW(pB0,6)};pw1=(u32x4){PKW(pB0,8),PKW(pB0,10),PKW(pB0,12),PKW(pB0,14)};pw2=(u32x4){PKW(pB1,0),PKW(pB1,2),PKW(pB1,4),PKW(pB1,6)};pw3=(u32x4){PKW(pB1,8),PKW(pB1,10),PKW(pB1,12),PKW(pB1,14)};
    SBAR(); pv(o,vb0+2*sl_cur,PAF(0),PAF(1),PAF(2),PAF(3)); pv(o+2,vb0+2*sl_cur+SLOTB,PAF(0),PAF(1),PAF(2),PAF(3)); }
  #undef PKW
  #undef PAF
  #undef VFR
  #undef PIN
  #undef MX3
  #undef GAPA
  #undef GAPB
  #undef EX
  #undef VRD
  #undef VRD2
  #undef KRD
  #undef STEP
  #undef ENDW
  {auto rr=__builtin_amdgcn_permlane32_swap(__float_as_uint(l_reg),__float_as_uint(l_reg),false,false);l_reg=__uint_as_float(rr[0])+__uint_as_float(rr[1]);}
  if(hi==0)wsf[32+r32]=l_reg;asm volatile("s_waitcnt lgkmcnt(0)":::"memory");
  float rli[16];
  #pragma unroll
  for(int r=0;r<16;++r)rli[r]=__builtin_amdgcn_rcpf(wsf[32+crow(r,hi)]);
  bf16*Ow=Ou+(long)(wid*QBLK)*DM;
  { bf16*stg=(bf16*)(shm+LDS_OST)+wid*2048;
    #pragma unroll
    for(int hv=0;hv<2;++hv){
      #pragma unroll
      for(int r=0;r<16;++r){const int orow=crow(r,hi);
        #pragma unroll
        for(int d0=0;d0<2;++d0)stg[orow*64+d0*32+r32]=__float2bfloat16(o[2*hv+d0][r]*rli[r]);}
      asm volatile("s_waitcnt lgkmcnt(0)":::"memory");
      #pragma unroll
      for(int i=0;i<4;++i){const int row=i*8+(lane>>3),ch=lane&7; const u32x4 v=*(const u32x4*)(stg+row*64+ch*8); ATTN_STORE16(Ow+(long)row*DM+hv*64+ch*8,v);}
      asm volatile("s_waitcnt lgkmcnt(0)":::"memory"); } }
  asm volatile("s_waitcnt lgkmcnt(0)\n\ts_barrier":::"memory");
  #undef DMA_K
  #undef DMA_V
  #undef CMASK
  #undef START
  #undef RESC
  #undef ROT
}
constexpr int ATTN_LDS_BYTES=LDS_BYTES;
#undef SBAR
#undef WAIT_BAR
}
constexpr int NWAVES = 8, NTHREADS = 512;
constexpr int D = 1024, SEQ = 8192, CTXL = 256, LAT = 16384, MT = 16896, NCTX = 512, DFF = 2816, INW = 5632;
constexpr float EPS = 1e-6f;
constexpr size_t MiB = 1u << 20;
constexpr size_t WS_MOD = 0;
constexpr size_t WS_LAM = 256 * 1024;
constexpr size_t WS_ROPE = 288 * 1024;
constexpr size_t WS_TW8192 = 320 * 1024;
constexpr size_t WS_TW256 = 384 * 1024;
constexpr size_t WS_WB = 512 * 1024;
constexpr size_t WS_WC = 640 * 1024;
constexpr size_t WS_WBD = 1 * MiB;
constexpr size_t WS_W = 2 * MiB;
constexpr size_t W_FI0 = 0, W_FI1 = 5767168, W_FO0 = 11534336, W_FO1 = 14417920, W_IN = 17301504, W_AO = 23068672, W_FR = 24117248, W_O = 24641536;
constexpr size_t WS_X = 51 * MiB;
constexpr size_t WS_U = 117 * MiB;
constexpr size_t WS_R = 150 * MiB;
constexpr size_t WS_Q = WS_R, WS_K = WS_R + 33 * MiB, WS_V = WS_R + 66 * MiB, WS_F = WS_R + 99 * MiB, WS_O0 = WS_F + 33 * MiB / 2, WS_O1 = WS_O0 + 33 * MiB;
constexpr size_t WS_H = WS_R, WS_Z = WS_Q, WS_G = WS_K, WS_FM = WS_F, WS_MG = WS_O1;
constexpr size_t WS_FMC = WS_O1 + 33 * MiB;
constexpr size_t WS_SLOTS = WS_FMC + 2 * MiB;
constexpr size_t WS_CNT = WS_FMC + 4 * MiB;
constexpr size_t WS_END = WS_FMC + 16 * MiB;
constexpr int LDS_BYTES = 147456;

#define LAS __attribute__((address_space(3)))
typedef unsigned short bf16;
typedef unsigned v4u __attribute__((ext_vector_type(4)));
typedef float f32x4 __attribute__((ext_vector_type(4)));
typedef float f32x16 __attribute__((ext_vector_type(16)));
typedef short bf16x8 __attribute__((ext_vector_type(8)));
typedef pg8::cs2_t cs2;
__device__ __forceinline__ unsigned f2bf(float f) { unsigned u = __builtin_bit_cast(unsigned, f); return (u + 0x7fffu + ((u >> 16) & 1u)) >> 16; }
__device__ __forceinline__ unsigned pk2(float lo, float hi) { return f2bf(lo) | (f2bf(hi) << 16); }
__device__ __forceinline__ float blo(unsigned w) { return __builtin_bit_cast(float, w << 16); }
__device__ __forceinline__ float bhi(unsigned w) { return __builtin_bit_cast(float, w & 0xffff0000u); }
template <int M> __device__ __forceinline__ float swz_xor(float v) { return __builtin_bit_cast(float, __builtin_amdgcn_ds_swizzle(__builtin_bit_cast(int, v), 0x1f | (M << 10))); }
__device__ __forceinline__ float wave_sum(float v) {
    v += swz_xor<1>(v); v += swz_xor<2>(v); v += swz_xor<4>(v); v += swz_xor<8>(v); v += swz_xor<16>(v);
    const int vb = __builtin_bit_cast(int, v);
    return __builtin_bit_cast(float, __builtin_amdgcn_readlane(vb, 0)) + __builtin_bit_cast(float, __builtin_amdgcn_readlane(vb, 32));
}
struct Args { const float* in[17]; float* out; unsigned char* ws; int ph_lo, ph_hi; };
enum { I_X = 0, I_C, I_CTX, I_CCTX, I_WMOD, I_BMOD, I_NORMG, I_FWIN, I_FWOUT, I_WIN, I_BGATE, I_LAM, I_SUBLN, I_WAO, I_WFO, I_WO, I_FINALG };

__device__ __forceinline__ void transpose_item(const float* W, int K, int N, bf16* WT, int drow0, LAS float* scr, int k0, int n0, int lane) {
    float wv[32];
#pragma unroll
    for (int i = 0; i < 32; ++i) wv[i] = W[(size_t)(k0 + 2 * i + (lane >> 5)) * N + n0 + (lane & 31)];
#pragma unroll
    for (int i = 0; i < 32; ++i) scr[(2 * i + (lane >> 5)) * 33 + (lane & 31)] = wv[i];
    asm volatile("s_waitcnt lgkmcnt(0)" ::: "memory");
    const int c = lane & 7;
#pragma unroll
    for (int j = 0; j < 4; ++j) { const int n = (lane >> 3) + 8 * j; const LAS float* s = scr + (8 * c) * 33 + n;
        v4u o; o.x = pk2(s[0 * 33], s[1 * 33]); o.y = pk2(s[2 * 33], s[3 * 33]); o.z = pk2(s[4 * 33], s[5 * 33]); o.w = pk2(s[6 * 33], s[7 * 33]);
        *(v4u*)(WT + (size_t)(drow0 + n) * K + k0 + 8 * c) = o; }
    asm volatile("s_waitcnt lgkmcnt(0)" ::: "memory");
}
__device__ __forceinline__ void convert_weights(const Args& a, int l, LAS unsigned char* lds, int gw, int NGW, int wave, int lane) {
    LAS float* scr = (LAS float*)(lds + wave * 16384);
    bf16* WB = (bf16*)(a.ws + WS_W);
    constexpr int I_FI = 16 * 176, I_FO = 44 * 32, I_IN = 16 * 176, I_SQ = 16 * 32, I_FR = 8 * 32;
    constexpr int NITEMS = 2 * I_FI + 2 * I_FO + I_IN + 2 * I_SQ + I_FR;
    for (int it = gw; it < NITEMS; it += NGW) {
        int r = it;
        if (r < 2 * I_FI) { const int i = r / I_FI; r -= i * I_FI; const int kb = r / 176, nb = r % 176, n0 = 32 * nb;
            const int drow = n0 < DFF ? (n0 / 128) * 256 + (n0 % 128) : ((n0 - DFF) / 128) * 256 + 128 + ((n0 - DFF) % 128);
            transpose_item(a.in[I_FWIN] + (size_t)(l * 2 + i) * D * INW, D, INW, WB + (i ? W_FI1 : W_FI0), drow, scr, 64 * kb, n0, lane); continue; }
        r -= 2 * I_FI;
        if (r < 2 * I_FO) { const int i = r / I_FO; r -= i * I_FO; const int kb = r / 32, nb = r % 32;
            transpose_item(a.in[I_FWOUT] + (size_t)(l * 2 + i) * DFF * D, DFF, D, WB + (i ? W_FO1 : W_FO0), 32 * nb, scr, 64 * kb, 32 * nb, lane); continue; }
        r -= 2 * I_FO;
        if (r < I_IN) { const int kb = r / 176, nb = r % 176; transpose_item(a.in[I_WIN] + (size_t)l * D * INW, D, INW, WB + W_IN, 32 * nb, scr, 64 * kb, 32 * nb, lane); continue; }
        r -= I_IN;
        if (r < I_SQ) { const int kb = r / 32, nb = r % 32; transpose_item(a.in[I_WAO] + (size_t)l * D * D, D, D, WB + W_AO, 32 * nb, scr, 64 * kb, 32 * nb, lane); continue; }
        r -= I_SQ;
        if (r < I_SQ) { const int kb = r / 32, nb = r % 32; transpose_item(a.in[I_WO] + (size_t)l * D * D, D, D, WB + W_O, 32 * nb, scr, 64 * kb, 32 * nb, lane); continue; }
        r -= I_SQ;
        { const int kb = r / 32, nb = r % 32; transpose_item(a.in[I_WFO] + (size_t)l * 512 * D, 512, D, WB + W_FR, 32 * nb, scr, 64 * kb, 32 * nb, lane); }
    }
}
__device__ __forceinline__ void norm_rows(const float* src_lat, const float* src_ctx, int nrows, const float* g, const float* mod  , bf16* U, int gw, int NGW, int lane, int row0 = 0) {
    f32x4 gv[4], shv[4], scv[4], v[4];
#pragma unroll
    for (int j = 0; j < 4; ++j) gv[j] = ((const f32x4*)g)[lane + 64 * j];
    int cur_mb = -1, row = row0 + gw;
    if (row < nrows) { const f32x4* xr = (const f32x4*)(row < LAT ? src_lat + (size_t)row * D : src_ctx + (size_t)(row - LAT) * D) + lane;
#pragma unroll
        for (int j = 0; j < 4; ++j) v[j] = xr[64 * j]; }
    while (row < nrows) {
        const int mb = row < LAT ? (row >> 13) : 2;
        if (mb != cur_mb) { cur_mb = mb; const f32x4* sh = (const f32x4*)(mod + mb * 9216) + lane; const f32x4* sc = (const f32x4*)(mod + mb * 9216 + 1024) + lane;
#pragma unroll
            for (int j = 0; j < 4; ++j) { shv[j] = sh[64 * j]; scv[j] = sc[64 * j] + 1.0f; } }
        const int nxt = row + NGW; f32x4 vn[4];
        if (nxt < nrows) { const f32x4* xr = (const f32x4*)(nxt < LAT ? src_lat + (size_t)nxt * D : src_ctx + (size_t)(nxt - LAT) * D) + lane;
#pragma unroll
            for (int j = 0; j < 4; ++j) vn[j] = xr[64 * j]; }
        float s = 0.f;
#pragma unroll
        for (int j = 0; j < 4; ++j) s += (v[j].x * v[j].x + v[j].y * v[j].y) + (v[j].z * v[j].z + v[j].w * v[j].w);
        const float rstd = 1.f / sqrtf(wave_sum(s) * (1.f / D) + EPS);
        unsigned long long* o8 = (unsigned long long*)(U + (size_t)row * D) + lane;
#pragma unroll
        for (int j = 0; j < 4; ++j) { const f32x4 y = v[j] * rstd * gv[j]; const f32x4 o = y * scv[j] + shv[j];
            o8[64 * j] = (unsigned long long)pk2(o.x, o.y) | ((unsigned long long)pk2(o.z, o.w) << 32); }
#pragma unroll
        for (int j = 0; j < 4; ++j) v[j] = vn[j];
        row = nxt;
    }
}
__device__ __forceinline__ void final_norm(const float* src, const float* g, float* out, int gw, int NGW, int lane) {
    f32x4 gv[4], v[4];
#pragma unroll
    for (int j = 0; j < 4; ++j) gv[j] = ((const f32x4*)g)[lane + 64 * j];
    int row = gw;
    if (row < LAT) { const f32x4* xr = (const f32x4*)(src + (size_t)row * D) + lane;
#pragma unroll
        for (int j = 0; j < 4; ++j) v[j] = xr[64 * j]; }
    while (row < LAT) {
        const int nxt = row + NGW; f32x4 vn[4];
        if (nxt < LAT) { const f32x4* xr = (const f32x4*)(src + (size_t)nxt * D) + lane;
#pragma unroll
            for (int j = 0; j < 4; ++j) vn[j] = xr[64 * j]; }
        float s = 0.f;
#pragma unroll
        for (int j = 0; j < 4; ++j) s += (v[j].x * v[j].x + v[j].y * v[j].y) + (v[j].z * v[j].z + v[j].w * v[j].w);
        const float rstd = 1.f / sqrtf(wave_sum(s) * (1.f / D) + EPS);
        f32x4* o = (f32x4*)(out + (size_t)row * D) + lane;
#pragma unroll
        for (int j = 0; j < 4; ++j) o[64 * j] = v[j] * rstd * gv[j];
#pragma unroll
        for (int j = 0; j < 4; ++j) v[j] = vn[j];
        row = nxt;
    }
}
__device__ __forceinline__ void combine_rows(bf16* O0, const bf16* O1, int nrows, float lam, float oml, const float* subg, int gw, int NGW, int lane) {
    float sg[16];
#pragma unroll
    for (int j = 0; j < 16; ++j) sg[j] = subg[(lane & 7) * 16 + j] * oml;
    int row = gw; v4u a[2], b[2];
    if (row < nrows) { const v4u* p0 = (const v4u*)(O0 + (size_t)row * D + lane * 16); const v4u* p1 = (const v4u*)(O1 + (size_t)row * D + lane * 16); a[0] = p0[0]; a[1] = p0[1]; b[0] = p1[0]; b[1] = p1[1]; }
    while (row < nrows) {
        const int nxt = row + NGW; v4u an[2], bn[2];
        if (nxt < nrows) { const v4u* p0 = (const v4u*)(O0 + (size_t)nxt * D + lane * 16); const v4u* p1 = (const v4u*)(O1 + (size_t)nxt * D + lane * 16); an[0] = p0[0]; an[1] = p0[1]; bn[0] = p1[0]; bn[1] = p1[1]; }
        float av[16]; float s = 0.f;
#pragma unroll
        for (int h = 0; h < 2; ++h)
#pragma unroll
            for (int j = 0; j < 4; ++j) { const float x0 = blo(a[h][j]) - lam * blo(b[h][j]), x1 = bhi(a[h][j]) - lam * bhi(b[h][j]); av[h * 8 + 2 * j] = x0; av[h * 8 + 2 * j + 1] = x1; s += x0 * x0 + x1 * x1; }
        s += swz_xor<1>(s); s += swz_xor<2>(s); s += swz_xor<4>(s);
        const float r = 1.f / sqrtf(s * (1.f / 128.f) + EPS);
        v4u* po = (v4u*)(O0 + (size_t)row * D + lane * 16);
#pragma unroll
        for (int h = 0; h < 2; ++h) { v4u o;
#pragma unroll
            for (int j = 0; j < 4; ++j) o[j] = pk2(av[h * 8 + 2 * j] * r * sg[h * 8 + 2 * j], av[h * 8 + 2 * j + 1] * r * sg[h * 8 + 2 * j + 1]);
            po[h] = o; }
        a[0] = an[0]; a[1] = an[1]; b[0] = bn[0]; b[1] = bn[1];
        row = nxt;
    }
}
__device__ __forceinline__ void mod_gemv(const Args& a, LAS unsigned char* lds, int bid, int G, int tid, int wave, int lane) {
    LAS float* sil = (LAS float*)lds;
    LAS float* red = (LAS float*)(lds + 12288);
    float* mod = (float*)(a.ws + WS_MOD);
    for (int i = tid; i < 3072; i += NTHREADS) { const int mb = i >> 10, k = i & 1023; const float c = mb < 2 ? a.in[I_C][mb * 1024 + k] : a.in[I_CCTX][k]; sil[i] = c / (1.f + expf(-c)); }
    __syncthreads();
    for (int it = bid; it < 288; it += G) {
        const int l = it / 144, cgp = it % 144, col = cgp * 64 + lane;
        const float* W = a.in[I_WMOD] + (size_t)l * 1024 * 9216 + col; const int k0 = wave * 128;
        float a0 = 0.f, a1 = 0.f, a2 = 0.f;
#pragma unroll
        for (int kb = 0; kb < 128; kb += 32) { float wv[32];
#pragma unroll
            for (int i = 0; i < 32; ++i) wv[i] = W[(size_t)(k0 + kb + i) * 9216];
#pragma unroll
            for (int i = 0; i < 32; ++i) { const int k = k0 + kb + i; a0 += sil[k] * wv[i]; a1 += sil[1024 + k] * wv[i]; a2 += sil[2048 + k] * wv[i]; } }
        red[(wave * 3 + 0) * 64 + lane] = a0; red[(wave * 3 + 1) * 64 + lane] = a1; red[(wave * 3 + 2) * 64 + lane] = a2;
        __syncthreads();
        if (tid < 192) { const int mb = tid >> 6, ln = tid & 63; float s = 0.f;
#pragma unroll
            for (int w = 0; w < 8; ++w) s += red[(w * 3 + mb) * 64 + ln];
            mod[l * 27648 + mb * 9216 + cgp * 64 + ln] = s + a.in[I_BMOD][l * 9216 + cgp * 64 + ln]; }
        __syncthreads();
    }
}
__device__ __forceinline__ void make_tables(const Args& a, int gtid, int NT_) {
    cs2* rope = (cs2*)(a.ws + WS_ROPE); cs2* tw = (cs2*)(a.ws + WS_TW8192); cs2* tw256 = (cs2*)(a.ws + WS_TW256);
    bf16* Wb = (bf16*)(a.ws + WS_WB); bf16* Wc = (bf16*)(a.ws + WS_WC); bf16* WBD = (bf16*)(a.ws + WS_WBD);
    for (int i = gtid; i < 2048; i += NT_) { const int pos = i >> 4, f = i & 15; const float inv = 1.0f / powf(10000.0f, (float)(2 * f) / 32.0f); const float ang = (float)pos * inv; cs2 v; v.x = cosf(ang); v.y = sinf(ang); rope[i] = v; }
    for (int i = gtid; i < 8192; i += NT_) { cs2 v; v.x = cospif((float)i / 4096.0f); v.y = sinpif((float)i / 4096.0f); tw[i] = v; }
    for (int i = gtid; i < 256; i += NT_) { cs2 v; v.x = cospif((float)i / 128.0f); v.y = sinpif((float)i / 128.0f); tw256[i] = v; }
    for (int i = gtid; i < 65536; i += NT_) { const int m = i >> 8, k = i & 255, ap = m >> 1, ro = m & 1, aa = k >> 1, ri = k & 1; const int idx = (ap * aa) & 127;
        const float c = cospif((float)idx / 64.0f), s = sinpif((float)idx / 64.0f); const float v = (ro == ri) ? c : (ro == 0 ? s : -s); Wb[i] = (bf16)f2bf(v); }
    for (int i = gtid; i < 8192; i += NT_) { const int rp = i >> 7, k = i & 127, r = k >> 1, ro = k & 1; const int idx = (rp * r) & 63;
        const float v = ro == 0 ? cospif((float)idx / 32.0f) : sinpif((float)idx / 32.0f); Wc[i] = (bf16)f2bf(v); }
    for (int i = gtid; i < 1024 * 512; i += NT_) { const int n = i >> 9, k = i & 511; const int cc = n >> 1, reim = n & 1, g = cc >> 7, cp = cc & 127, g2 = k >> 7, c = k & 127;
        float v = 0.f; if (g == g2) { const int idx = (c * cp) & 127; v = reim == 0 ? cospif((float)idx / 64.0f) : -sinpif((float)idx / 64.0f); } WBD[i] = (bf16)f2bf(v); }
    { bf16* Wx = (bf16*)(a.ws + WS_FMC);
      for (int i = gtid; i < 512 * 1024; i += NT_) { const int row = i >> 10, k = i & 1023, b = row >> 8, sp = row & 255, b2 = k >> 9, s_ = (k >> 1) & 255, ri = k & 1;
          float v = 0.f; if (b == b2) { const int idx = (s_ * sp) & 255; v = ri == 0 ? cospif((float)idx / 128.0f) : sinpif((float)idx / 128.0f); } Wx[i] = (bf16)f2bf(v); } }
    if (gtid < 2) {
        const int l = gtid; const float* lp = a.in[I_LAM] + l * 256; float s1 = 0.f, s2 = 0.f;
        for (int d = 0; d < 64; ++d) { s1 += lp[d] * lp[64 + d]; s2 += lp[128 + d] * lp[192 + d]; }
        const float lam_init = 0.8f - 0.6f * expf(-0.3f * (float)l);
        ((float*)(a.ws + WS_LAM))[l] = expf(s1) - expf(s2) + lam_init;
    }
}
__device__ __forceinline__ void seqdft_lat(const Args& a, LAS unsigned char* lds, int bid, int G, int tid, int wave, int lane) {
    const bf16* Z = (const bf16*)(a.ws + WS_Z); bf16* FMc = (bf16*)(a.ws + WS_FMC);
    const bf16* Wb = (const bf16*)(a.ws + WS_WB); const bf16* Wc = (const bf16*)(a.ws + WS_WC); const cs2* tw = (const cs2*)(a.ws + WS_TW8192);
    const int r32 = lane & 31, hi = lane >> 5, w = wave;
    for (int job = bid; job < 512; job += G) {
        const int b = job >> 8, chunk = job & 255;
        const v4u* src = (const v4u*)(Z + (size_t)(b * 256 + chunk) * 8192 * 4);
#pragma unroll
        for (int i = 0; i < 8; ++i) ((LAS v4u*)lds)[i * 512 + tid] = src[i * 512 + tid];
        __syncthreads();
        f32x16 acc[4];
#pragma unroll
        for (int nt = 0; nt < 4; ++nt) acc[nt] = f32x16{};
        const bf16* wrow = Wb + (32 * w + r32) * 256 + 8 * hi;
#pragma unroll 4
        for (int kt = 0; kt < 16; ++kt) {
            const bf16x8 af = *(const bf16x8*)(wrow + 16 * kt);
#pragma unroll
            for (int nt = 0; nt < 4; ++nt) {
                const LAS unsigned char* p = lds + 512 * (8 * kt + 4 * hi) + 4 * (32 * nt + r32);
                v4u wv; wv.x = *(const LAS unsigned*)(p); wv.y = *(const LAS unsigned*)(p + 512); wv.z = *(const LAS unsigned*)(p + 1024); wv.w = *(const LAS unsigned*)(p + 1536);
                acc[nt] = __builtin_amdgcn_mfma_f32_32x32x16_bf16(af, __builtin_bit_cast(bf16x8, wv), acc[nt], 0, 0, 0);
            }
        }
#pragma unroll
        for (int nt = 0; nt < 4; ++nt) { const int n = 32 * nt + r32, r = n >> 1, cj = n & 1;
#pragma unroll
            for (int p = 0; p < 8; ++p) { const int ap = 16 * w + (p & 1) + 4 * (p >> 1) + 2 * hi; const float tr = acc[nt][2 * p], ti = acc[nt][2 * p + 1]; const cs2 cs = tw[r * ap];
                const float re = tr * cs.x + ti * cs.y, im = ti * cs.x - tr * cs.y;
                *(LAS unsigned*)(lds + 65536 + (2 * ap + cj) * 272 + 4 * r) = pk2(re, im); } }
        __syncthreads();
        f32x16 c2[2]; c2[0] = f32x16{}; c2[1] = f32x16{};
#pragma unroll
        for (int kt = 0; kt < 8; ++kt) {
            const bf16x8 bfr = *(const LAS bf16x8*)(lds + 65536 + (32 * w + r32) * 272 + (16 * kt + 8 * hi) * 2);
#pragma unroll
            for (int mt = 0; mt < 2; ++mt) { const bf16x8 af = *(const bf16x8*)(Wc + (32 * mt + r32) * 128 + 16 * kt + 8 * hi); c2[mt] = __builtin_amdgcn_mfma_f32_32x32x16_bf16(af, bfr, c2[mt], 0, 0, 0); }
        }
        { int ln2 = lane; asm volatile("" : "+v"(ln2));
          const int r32o = ln2 & 31, hio = ln2 >> 5; unsigned char* wsl = a.ws; asm volatile("" : "+s"(wsl)); bf16* FMo = (bf16*)(wsl + WS_FM);
          const int n2 = 32 * w + r32o, ap2 = n2 >> 1, cj2 = n2 & 1;
#pragma unroll
          for (int mt = 0; mt < 2; ++mt)
#pragma unroll
            for (int r16 = 0; r16 < 16; ++r16) { const int rp = 32 * mt + (r16 & 3) + 8 * (r16 >> 2) + 4 * hio; const int tok = ap2 + 128 * rp;
                FMo[(size_t)(b * 8192 + tok) * 512 + chunk * 2 + cj2] = (bf16)f2bf(c2[mt][r16] * (1.0f / 1024.0f)); } }
        __syncthreads();
    }
}
__device__ __forceinline__ void seqdft_ctx(const Args& a, int gtid, int NT_) {
    const bf16* Zc = (const bf16*)(a.ws + WS_Z) + (size_t)LAT * 1024; bf16* FM = (bf16*)(a.ws + WS_FM); const cs2* tw256 = (const cs2*)(a.ws + WS_TW256);
    for (int o = gtid; o < 2 * 256 * 512; o += NT_) {
        const int sp = o & 255, cc = (o >> 8) & 511, b = o >> 17, chunk = cc >> 1, cj = cc & 1;
        const unsigned* z = (const unsigned*)(Zc + (size_t)((b * 256 + chunk) * 256) * 4 + cj * 2);
        float acc = 0.f;
#pragma unroll 16
        for (int s = 0; s < 256; ++s) { const unsigned wv = z[s * 2]; const cs2 cs = tw256[(s * sp) & 255]; acc += blo(wv) * cs.x + bhi(wv) * cs.y; }
        FM[(size_t)(LAT + b * 256 + sp) * 512 + cc] = (bf16)f2bf(acc * 0.005524271728f);
    }
}

__device__ __forceinline__ void fm_transpose(const Args& a, LAS unsigned char* lds, int bid, int G, int tid) {
    const unsigned* FMc = (const unsigned*)(a.ws + WS_FMC); unsigned* FM = (unsigned*)(a.ws + WS_FM);
    LAS unsigned* T = (LAS unsigned*)lds;
    for (int item = bid; item < 256; item += G) {
        const int b = item >> 7, tt = item & 127;
#pragma unroll 8
        for (int it = 0; it < 32; ++it) { const int i = it * 512 + tid, chunk = i >> 6, tokl = i & 63; T[chunk * 65 + tokl] = FMc[(size_t)(b * 256 + chunk) * 8192 + tt * 64 + tokl]; }
        __syncthreads();
#pragma unroll 8
        for (int it = 0; it < 32; ++it) { const int i = it * 512 + tid, tokl = i >> 8, chunk = i & 255; FM[(size_t)(b * 8192 + tt * 64 + tokl) * 256 + chunk] = T[chunk * 65 + tokl]; }
        __syncthreads();
    }
}

#define XB_TMO      128
#define XB_XCNT(j)  (256  + 64 * (j))
#define XB_XSUB(j)  (1280 + 64 * (j))
#define XB_XGEN(j)  (2304 + 64 * (j))
#define XB_TOP      3328
#define XB_TOPGEN   3392
#define XCD_BAR_WORDS 3456
#define XB_SPIN_CAP (1u << 18)

__device__ __forceinline__ unsigned xb_ld(unsigned* p)              { return __hip_atomic_load(p, __ATOMIC_RELAXED, __HIP_MEMORY_SCOPE_AGENT); }
__device__ __forceinline__ unsigned xb_add(unsigned* p, unsigned v) { return __hip_atomic_fetch_add(p, v, __ATOMIC_RELAXED, __HIP_MEMORY_SCOPE_AGENT); }
__device__ __forceinline__ unsigned xb_xcc_id() { return (unsigned)__builtin_amdgcn_s_getreg((3 << 11) | 20) & 0xFu; }
#define XB_SPIN(cond, bar) do { unsigned _sp = 0; while (cond) { __builtin_amdgcn_s_sleep(1); \
    if ((++_sp & 255u) == 0u) { if (xb_ld(&(bar)[XB_TMO])) break; if (_sp > XB_SPIN_CAP) { atomicAdd(&(bar)[XB_TMO], 1u); break; } } } } while (0)

struct XcdBarrier {
    unsigned* bar; unsigned x;
    volatile LAS unsigned* st;
};

__device__ __forceinline__ XcdBarrier xcd_barrier_post(unsigned* bar, volatile LAS unsigned* st) {
    XcdBarrier b; b.bar = bar; b.x = xb_xcc_id(); b.st = st;
    if (threadIdx.x == 0) (void)xb_add(&bar[XB_XCNT(b.x)], 1u);
    return b;
}
__device__ __forceinline__ void xcd_barrier_complete(unsigned* bar, unsigned x, unsigned& nloc, unsigned& nx) {
    const unsigned G = gridDim.x * gridDim.y * gridDim.z;
    unsigned sum, cnt, mine, sp = 0u;
    for (;;) {
        sum = 0u; cnt = 0u; mine = 0u;
#pragma unroll
        for (unsigned j = 0; j < 16; ++j) { const unsigned c = xb_ld(&bar[XB_XCNT(j)]); sum += c; cnt += (c > 0u) ? 1u : 0u; mine = (j == x) ? c : mine; }
        if (sum == G) break;
        __builtin_amdgcn_s_sleep(1);
        if ((++sp & 255u) == 0u) { if (xb_ld(&bar[XB_TMO])) break; if (sp > XB_SPIN_CAP) { atomicAdd(&bar[XB_TMO], 1u); break; } }
    }
    nloc = mine > 0u ? mine : 1u; nx = cnt > 0u ? cnt : 1u;
}

__device__ __forceinline__ void xcd_barrier(const XcdBarrier& b) {
    asm volatile("s_waitcnt vmcnt(0)" ::: "memory");
    __syncthreads();
    if (threadIdx.x == 0) {
        unsigned* bar = b.bar;
        __builtin_amdgcn_s_waitcnt(0);
        unsigned nloc = b.st[0], nx = b.st[1];
        if (nloc == 0u) { xcd_barrier_complete(bar, b.x, nloc, nx); b.st[0] = nloc; b.st[1] = nx; }
        const unsigned old = xb_add(&bar[XB_XSUB(b.x)], 1u);
        const unsigned gen = old / nloc;
        if (old + 1u == (gen + 1u) * nloc) {
            __builtin_amdgcn_fence(__ATOMIC_RELEASE, "agent");
            asm volatile("s_waitcnt vmcnt(0)" ::: "memory");
            const unsigned og = xb_add(&bar[XB_TOP], 1u);
            const unsigned tg = og / nx;
            if (og + 1u == (tg + 1u) * nx) xb_add(&bar[XB_TOPGEN], 1u);
            else XB_SPIN(xb_ld(&bar[XB_TOPGEN]) == tg, bar);
            __builtin_amdgcn_fence(__ATOMIC_ACQUIRE, "agent");
            xb_add(&bar[XB_XGEN(b.x)], 1u);
            asm volatile("s_waitcnt vmcnt(0)" ::: "memory");
        } else {
            XB_SPIN(xb_ld(&bar[XB_XGEN(b.x)]) == gen, bar);
            __builtin_amdgcn_fence(__ATOMIC_ACQUIRE, "agent");
            asm volatile("s_waitcnt vmcnt(0)" ::: "memory");
        }
    }
    __syncthreads();
}

constexpr size_t WS_BAR = 448 * 1024;
constexpr int LDS_MISC = LDS_BYTES - 64;

struct CtxResid { const float* base; float* X; const float* gate; float coef;
    __device__ __forceinline__ void operator()(int row, int col, float v) const { const size_t o = (size_t)row * D + col; X[o] = base[o] + coef * gate[col] * v; } };
struct CtxGateMul { const bf16* G; bf16* MG; int goff; bool add;
    __device__ __forceinline__ void operator()(int row, int col, float v) const { const size_t o = (size_t)row * D + col; float r = pg8::bf2f(G[(size_t)row * 2048 + goff + col]) * v; if (add) r += pg8::bf2f(MG[o]); MG[o] = (bf16)f2bf(r); } };
struct CtxGates { bf16* G; const float* bias;
    __device__ __forceinline__ void operator()(int row, int col, float v) const { G[(size_t)row * 2048 + col] = (bf16)f2bf(1.0f / (1.0f + __expf(-(v + bias[col])))); } };
struct CtxChanDFT { bf16* Zc;
    __device__ __forceinline__ void operator()(int row, int col, float v) const { Zc[(size_t)(col >> 1) * 1024 + row * 2 + (col & 1)] = (bf16)f2bf(v); } };
struct CtxDftOut { bf16* FMc;
    __device__ __forceinline__ void operator()(int row, int col, float v) const { FMc[(size_t)row * 512 + col] = (bf16)f2bf(v * 0.005524271728f); } };
template <class F> __device__ __forceinline__ void ctx_gemm(const bf16* A, const bf16* Bt, int N, int K, LAS unsigned char* lds, int bid, int G, int wave, int lane, const F& epi) {
    const int r32 = lane & 31, hi = lane >> 5, ks = wave & 3, kq = K >> 2, ntn = N >> 5, npairs = 8 * ntn;
    LAS float* red = (LAS float*)lds;
    for (int tp = bid; tp < npairs; tp += G) {
        const int tile = 2 * tp + (wave >> 2), tm = tile / ntn, tn = tile % ntn;
        const bf16* ap = A + (size_t)(tm * 32 + r32) * K + ks * kq + 8 * hi; const bf16* bp = Bt + (size_t)(tn * 32 + r32) * K + ks * kq + 8 * hi;
        f32x16 acc = f32x16{};
#pragma unroll 8
        for (int k = 0; k < kq; k += 16) { const bf16x8 a = *(const bf16x8*)(ap + k), b = *(const bf16x8*)(bp + k); acc = __builtin_amdgcn_mfma_f32_32x32x16_bf16(a, b, acc, 0, 0, 0); }
#pragma unroll
        for (int r = 0; r < 16; ++r) red[(wave * 16 + r) * 64 + lane] = acc[r];
        __syncthreads();
        if (ks == 0) {
#pragma unroll
            for (int r = 0; r < 16; ++r) { const float v = (red[(wave * 16 + r) * 64 + lane] + red[((wave + 1) * 16 + r) * 64 + lane]) + (red[((wave + 2) * 16 + r) * 64 + lane] + red[((wave + 3) * 16 + r) * 64 + lane]);
                epi(tm * 32 + (r & 3) + 8 * (r >> 2) + 4 * hi, tn * 32 + r32, v); }
        }
        __syncthreads();
    }
}

#ifndef CUT
#define CUT -1
#endif
#ifndef DUMPSEL
#define DUMPSEL 0
#endif
__device__ __forceinline__ void dump_buf(const Args& args, int gtid, int NTH) {
    unsigned char* ws = args.ws; const bf16* U = (const bf16*)(ws + WS_U); const float* X = (const float*)(ws + WS_X);
    const bf16 *Qb = (const bf16*)(ws + WS_Q), *Kb = (const bf16*)(ws + WS_K), *Vb = (const bf16*)(ws + WS_V), *Fb = (const bf16*)(ws + WS_F), *O0 = (const bf16*)(ws + WS_O0), *O1 = (const bf16*)(ws + WS_O1);
    const bf16 *Hb = (const bf16*)(ws + WS_H), *Zb = (const bf16*)(ws + WS_Z), *Gb = (const bf16*)(ws + WS_G), *FMb = (const bf16*)(ws + WS_FM), *MGb = (const bf16*)(ws + WS_MG);
    for (size_t i = gtid; i < (size_t)LAT * D; i += NTH) { const size_t row = i >> 10; const int col = (int)(i & 1023); float v = 0.f;
        switch (DUMPSEL) {
            case 0: v = pg8::bf2f(U[i]); break;
            case 1: v = pg8::bf2f(Hb[row * DFF + col]) + pg8::bf2f(Hb[row * DFF + 1024 + col]) + pg8::bf2f(Hb[row * DFF + 1792 + col]); break;
            case 2: v = X[i]; break;
            case 3: v = pg8::bf2f(Qb[i]); break;
            case 4: v = pg8::bf2f(Kb[i]) + pg8::bf2f(Vb[i]); break;
            case 5: v = pg8::bf2f(Fb[row * 512 + (col & 511)]); break;
            case 6: v = pg8::bf2f(O0[i]) + pg8::bf2f(O1[i]); break;
            case 7: v = pg8::bf2f(O0[i]); break;
            case 8: v = pg8::bf2f(Zb[i]); break;
            case 9: v = pg8::bf2f(Gb[row * 2048 + col]) + pg8::bf2f(Gb[row * 2048 + 1024 + col]); break;
            case 10: v = pg8::bf2f(FMb[row * 512 + (col & 511)]); break;
            case 11: v = pg8::bf2f(MGb[i]); break;
            case 13: { const unsigned* gp = (const unsigned*)Gb; const unsigned w0 = __hip_atomic_load(gp + (row * 2048 + col) / 2, __ATOMIC_RELAXED, __HIP_MEMORY_SCOPE_AGENT), w1 = __hip_atomic_load(gp + (row * 2048 + 1024 + col) / 2, __ATOMIC_RELAXED, __HIP_MEMORY_SCOPE_AGENT);
                       v = ((col & 1) ? bhi(w0) : blo(w0)) + ((col & 1) ? bhi(w1) : blo(w1)); } break;
            case 14: v = (i < (size_t)2048 * 1024) ? pg8::bf2f(((const bf16*)(ws + WS_W))[W_IN + (size_t)3584 * 1024 + i]) : pg8::bf2f(((const bf16*)(ws + WS_W))[W_IN + (i - (size_t)2048 * 1024) % ((size_t)3584 * 1024)]); break;
            case 12: v = ((const float*)(ws + WS_MOD))[i % 55296]; break;
        }
        args.out[i] = v; }
}
constexpr int N_PHASES = 30;
typedef __attribute__((address_space(4))) const Args* kargp_t;
__device__ __forceinline__ kargp_t kargs() { kargp_t p = (kargp_t)__builtin_amdgcn_kernarg_segment_ptr(); asm volatile("" : "+s"(p)); return p; }
__device__ __forceinline__ Args load_args() { kargp_t p = kargs(); Args a;
#pragma unroll
    for (int i = 0; i < 17; ++i) a.in[i] = p->in[i];
    a.out = p->out; a.ws = p->ws; a.ph_lo = p->ph_lo; a.ph_hi = p->ph_hi; return a; }
__global__ void __launch_bounds__(NTHREADS, 2) fwd_mega(Args kernel_args) {
    extern __shared__ __attribute__((aligned(16))) unsigned char lds_raw[];
    LAS unsigned char* lds = (LAS unsigned char*)lds_raw;
    cg::grid_group grid = cg::this_grid();
    const int lo = kargs()->ph_lo, hi = kargs()->ph_hi;
    if (threadIdx.x < 16) ((LAS unsigned*)(lds + LDS_MISC))[threadIdx.x] = 0u;
    if (blockIdx.x == 0) { for (int i = threadIdx.x; i < XCD_BAR_WORDS; i += NTHREADS) ((unsigned*)(kargs()->ws + WS_BAR))[i] = 0u; for (int i = threadIdx.x; i < 6 * 4096; i += NTHREADS) ((unsigned*)(kargs()->ws + WS_CNT))[i] = 0u; __builtin_amdgcn_fence(__ATOMIC_RELEASE, "agent"); asm volatile("s_waitcnt vmcnt(0)" ::: "memory"); }
    __syncthreads();
    grid.sync();
    if (threadIdx.x == 0) (void)xb_add((unsigned*)(kargs()->ws + WS_BAR) + XB_XCNT(xb_xcc_id()), 1u);
#define LY_LOCALS const float* modl = mod + l * 27648; const float* ng = args.in[I_NORMG] + l * 3 * 1024; const float* src_lat = (l == 0) ? args.in[I_X] : X; const float* src_ctx = (l == 0) ? args.in[I_CTX] : X + (size_t)LAT * D; (void)modl; (void)ng; (void)src_lat; (void)src_ctx;
#define PH_LOCALS const Args args = load_args(); int tid = threadIdx.x; asm volatile("" : "+v"(tid)); const int lane = tid & 63, wave = __builtin_amdgcn_readfirstlane(tid >> 6); const int G = gridDim.x, bid = blockIdx.x; const int vcu = (G % 8 == 0) ? (bid % 8) * (G / 8) + bid / 8 : bid; const int gw = vcu * NWAVES + wave, NGW = G * NWAVES, gtid = bid * NTHREADS + tid, NTH = G * NTHREADS; (void)lane; (void)gw; (void)NGW; (void)gtid; (void)NTH; unsigned char* ws = args.ws; float* mod = (float*)(ws + WS_MOD); bf16* WB = (bf16*)(ws + WS_W); float* X = (float*)(ws + WS_X); bf16* U = (bf16*)(ws + WS_U); bf16 *Qb = (bf16*)(ws + WS_Q), *Kb = (bf16*)(ws + WS_K), *Vb = (bf16*)(ws + WS_V), *Fb = (bf16*)(ws + WS_F), *O0 = (bf16*)(ws + WS_O0), *O1 = (bf16*)(ws + WS_O1); bf16 *Hb = (bf16*)(ws + WS_H), *Zb = (bf16*)(ws + WS_Z), *Gb = (bf16*)(ws + WS_G), *FMb = (bf16*)(ws + WS_FM), *MGb = (bf16*)(ws + WS_MG); (void)mod; (void)WB; (void)X; (void)U; (void)Qb; (void)Kb; (void)Vb; (void)Fb; (void)O0; (void)O1; (void)Hb; (void)Zb; (void)Gb; (void)FMb; (void)MGb;
#ifndef REPMASK
#define REPMASK 0
#endif
#define PH_BEGIN(k) if (lo <= (k) && (k) < hi) { for (int rep_ = 0; rep_ < (((REPMASK >> ((k) == 0 ? 0 : ((k) == 29 ? 15 : 1 + ((k) - 1) % 14))) & 1) ? 2 : 1); ++rep_) { if (rep_) __syncthreads(); PH_LOCALS
#define PH_END(k) } if ((k) + 1 < hi) { XcdBarrier b_; b_.bar = (unsigned*)(kargs()->ws + WS_BAR); b_.x = xb_xcc_id(); b_.st = (volatile LAS unsigned*)(lds + LDS_MISC); xcd_barrier(b_); } else { __syncthreads(); } if (CUT == (k)) { const Args a2 = load_args(); dump_buf(a2, blockIdx.x * NTHREADS + threadIdx.x, gridDim.x * NTHREADS); return; } }
    using pg8::Gemm; using pg8::StaticOrder;
#define RUN_GEMM(EPI, Aptr, Bptr, Mrows, Ncols, Kdim, cidx, ...) do { Gemm g_{(const pg8::bf16_t*)(Aptr), (const pg8::bf16_t*)(Bptr), (Mrows), (Ncols), (Kdim)}; StaticOrder S_; S_.init((Mrows), (Ncols), G, (cidx)); \
        EPI E_{__VA_ARGS__}; pg8::gemm_phase<EPI, StaticOrder, true, true>(lds, g_, S_, E_); } while (0)

#define RUN_GEMM_AD(EPI, Aptr, Bptr, Mrows, Ncols, Kdim, cidx, ...) do { Gemm g_{(const pg8::bf16_t*)(Aptr), (const pg8::bf16_t*)(Bptr), (Mrows), (Ncols), (Kdim)}; StaticOrder S_; S_.init((Mrows), (Ncols), G, (cidx)); \
        EPI E_{__VA_ARGS__}; pg8::gemm_phase<EPI, StaticOrder, false, true>(lds, g_, S_, E_); } while (0)
#define EXCH(inst) pg8::RmsExchange{(unsigned*)(ws + WS_SLOTS) + (size_t)(inst) * LAT * 4, (unsigned*)(ws + WS_CNT) + (inst) * 4096}
    PH_BEGIN(0)
        mod_gemv(args, lds, bid, G, tid, wave, lane);
        make_tables(args, gtid, NTH);
        __syncthreads();
        convert_weights(args, 0, lds, gw, NGW, wave, lane);
    PH_END(0)

    for (int l = 0; l < 2; ++l) {
        const int pb = 1 + 14 * l;
        const bool last = (l == 1);
        const int Mtail = last ? LAT : MT;
        PH_BEGIN(pb + 0) LY_LOCALS
            if (l == 1 && G == 256) norm_rows(src_lat, src_ctx, MT, ng, modl, U, gw, NGW, lane, LAT);
            else norm_rows(src_lat, src_ctx, MT, ng, modl, U, gw, NGW, lane);
            if (l == 1) convert_weights(args, 1, lds, gw, NGW, wave, lane);
        PH_END(pb + 0)
        PH_BEGIN(pb + 1) LY_LOCALS
            RUN_GEMM(pg8::EpiSwiGLU, U, WB + W_FI0, MT, INW, D, bid, (pg8::bf16_t*)Hb);
        PH_END(pb + 1)
        PH_BEGIN(pb + 2) LY_LOCALS
            if (G == 256) RUN_GEMM_AD(pg8::EpiResidNorm<false>, Hb, WB + W_FO0, LAT, D, DFF, bid, src_lat, X, modl + 2 * 1024, 0.5f, ng + 1024, modl + 3 * 1024, (pg8::bf16_t*)U, (float*)nullptr, EXCH(3 * l + 0));
            else
            RUN_GEMM(pg8::EpiResid, Hb, WB + W_FO0, LAT, D, DFF, bid, src_lat, src_ctx, X, modl + 2 * 1024, 0.5f);
            __syncthreads();
            { const CtxResid ce{src_ctx, X + (size_t)LAT * D, modl + 2 * 9216 + 2 * 1024, 0.5f}; ctx_gemm(Hb + (size_t)LAT * DFF, WB + W_FO0, D, DFF, lds, bid, G, wave, lane, ce); }
        PH_END(pb + 2)
        PH_BEGIN(pb + 3) LY_LOCALS
            if (G == 256) norm_rows(X, X + (size_t)LAT * D, MT, ng + 1024, modl + 3 * 1024, U, gw, NGW, lane, LAT);
            else norm_rows(X, X + (size_t)LAT * D, MT, ng + 1024, modl + 3 * 1024, U, gw, NGW, lane);
        PH_END(pb + 3)
        PH_BEGIN(pb + 4) LY_LOCALS
            RUN_GEMM(pg8::EpiQKVF, U, WB + W_IN, MT, 3584, D, bid, (pg8::bf16_t*)Qb, (pg8::bf16_t*)Kb, (pg8::bf16_t*)Vb, (pg8::bf16_t*)Fb, (const pg8::cs2_t*)(ws + WS_ROPE));
        PH_END(pb + 4)
        PH_BEGIN(pb + 5) LY_LOCALS
            for (int id = vcu; id < 1024; id += G) {
                const int qb = id & 31, j = (id >> 5) & 15, b = id >> 9;
                const size_t qrow = (size_t)(b * SEQ + qb * 256) * D, kvrow = (size_t)b * 8448 * D; const int vcol = (j >> 1) * 128;
                attn_body::attn_unit<8>((const attn_body::bf16*)(Qb + qrow + j * 64), (const attn_body::bf16*)(Kb + kvrow + j * 64), (const attn_body::bf16*)(Vb + kvrow + vcol),
                                        (attn_body::bf16*)(((j & 1) ? O1 : O0) + qrow + vcol), 132, (char*)lds_raw);
            }
            if (!last) for (int id = vcu; id < 32; id += G) {
                const int j = id & 15, b = id >> 4;
                const size_t qrow = (size_t)(LAT + b * 256) * D, kvrow = (size_t)b * 8448 * D; const int vcol = (j >> 1) * 128;
                attn_body::attn_unit<8>((const attn_body::bf16*)(Qb + qrow + j * 64), (const attn_body::bf16*)(Kb + kvrow + j * 64), (const attn_body::bf16*)(Vb + kvrow + vcol),
                                        (attn_body::bf16*)(((j & 1) ? O1 : O0) + qrow + vcol), 4, (char*)lds_raw);
            }
        PH_END(pb + 5)
        PH_BEGIN(pb + 6) LY_LOCALS
            RUN_GEMM(pg8::EpiGates, U, WB + W_IN + (size_t)3584 * D, LAT, 2048, D, bid, (pg8::bf16_t*)Gb, args.in[I_BGATE] + l * 2048);
            __syncthreads();
            if (!last) { const CtxGates ce{Gb + (size_t)LAT * 2048, args.in[I_BGATE] + l * 2048}; ctx_gemm(U + (size_t)LAT * D, WB + W_IN + (size_t)3584 * D, 2048, D, lds, bid, G, wave, lane, ce); }
            __syncthreads();
#ifndef ONLYGATES
            { const float lam = ((const float*)(ws + WS_LAM))[l]; const float lam_init = 0.8f - 0.6f * expf(-0.3f * (float)l);
              combine_rows(O0, O1, Mtail, lam, 1.0f - lam_init, args.in[I_SUBLN] + l * 128, gw, NGW, lane); }
            __syncthreads();
            RUN_GEMM(pg8::EpiChanDFT, Fb, ws + WS_WBD, LAT, 1024, 512, bid, (pg8::bf16_t*)Zb);
            __syncthreads();
            if (!last) { const CtxChanDFT ce{Zb + (size_t)LAT * 1024}; ctx_gemm(Fb + (size_t)LAT * 512, (const bf16*)(ws + WS_WBD), 1024, 512, lds, bid, G, wave, lane, ce); }
            __syncthreads();
#endif
        PH_END(pb + 6)
        PH_BEGIN(pb + 7) LY_LOCALS
            seqdft_lat(args, lds, bid, G, tid, wave, lane);
            __syncthreads();
            if (!last) { const CtxDftOut ce{FMb + (size_t)LAT * 512}; ctx_gemm((const bf16*)(ws + WS_FMC), Zb + (size_t)LAT * 1024, 512, 1024, lds, bid, G, wave, lane, ce); }
        PH_END(pb + 7)
        PH_BEGIN(pb + 8) LY_LOCALS
            RUN_GEMM(pg8::EpiGateMul<false>, O0, WB + W_AO, LAT, D, D, bid, (const pg8::bf16_t*)Gb, (pg8::bf16_t*)MGb, 0);
            __syncthreads();
            RUN_GEMM(pg8::EpiGateMul<true>, FMb, WB + W_FR, LAT, D, 512, bid, (const pg8::bf16_t*)Gb, (pg8::bf16_t*)MGb, 1024);
            __syncthreads();
            if (!last) { const CtxGateMul ce{Gb + (size_t)LAT * 2048, MGb + (size_t)LAT * D, 0, false}; ctx_gemm(O0 + (size_t)LAT * D, WB + W_AO, D, D, lds, bid, G, wave, lane, ce); }
            __syncthreads();
            if (!last) { const CtxGateMul ce{Gb + (size_t)LAT * 2048, MGb + (size_t)LAT * D, 1024, true}; ctx_gemm(FMb + (size_t)LAT * 512, WB + W_FR, D, 512, lds, bid, G, wave, lane, ce); }
        PH_END(pb + 8)
        PH_BEGIN(pb + 10) LY_LOCALS
            if (G == 256) RUN_GEMM_AD(pg8::EpiResidNorm<false>, MGb, WB + W_O, LAT, D, D, bid, X, X, modl + 5 * 1024, 1.0f, ng + 2048, modl + 6 * 1024, (pg8::bf16_t*)U, (float*)nullptr, EXCH(3 * l + 1));
            else
            RUN_GEMM(pg8::EpiResid, MGb, WB + W_O, LAT, D, D, bid, X, X + (size_t)LAT * D, X, modl + 5 * 1024, 1.0f);
            __syncthreads();
            if (!last) { const CtxResid ce{X + (size_t)LAT * D, X + (size_t)LAT * D, modl + 2 * 9216 + 5 * 1024, 1.0f}; ctx_gemm(MGb + (size_t)LAT * D, WB + W_O, D, D, lds, bid, G, wave, lane, ce); }
        PH_END(pb + 10)
        if (!(last && gridDim.x == 256)) {
        PH_BEGIN(pb + 11) LY_LOCALS
            if (G == 256) norm_rows(X, X + (size_t)LAT * D, MT, ng + 2048, modl + 6 * 1024, U, gw, NGW, lane, LAT);
            else norm_rows(X, X + (size_t)LAT * D, Mtail, ng + 2048, modl + 6 * 1024, U, gw, NGW, lane);
        PH_END(pb + 11)
        }
        PH_BEGIN(pb + 12) LY_LOCALS
            RUN_GEMM(pg8::EpiSwiGLU, U, WB + W_FI1, Mtail, INW, D, bid, (pg8::bf16_t*)Hb);
        PH_END(pb + 12)
        PH_BEGIN(pb + 13) LY_LOCALS
            if (last && G == 256) RUN_GEMM_AD(pg8::EpiResidNorm<true>, Hb, WB + W_FO1, LAT, D, DFF, bid, X, X, modl + 8 * 1024, 0.5f, args.in[I_FINALG], modl, (pg8::bf16_t*)U, args.out, EXCH(3 * l + 2));
            else if (G == 256) RUN_GEMM_AD(pg8::EpiResidNorm<false>, Hb, WB + W_FO1, LAT, D, DFF, bid, X, X, modl + 8 * 1024, 0.5f, args.in[I_NORMG] + (l + 1) * 3 * 1024, mod + (l + 1) * 27648, (pg8::bf16_t*)U, (float*)nullptr, EXCH(3 * l + 2));
            else
            RUN_GEMM(pg8::EpiResid, Hb, WB + W_FO1, LAT, D, DFF, bid, X, X + (size_t)LAT * D, X, modl + 8 * 1024, 0.5f);
            __syncthreads();
            if (!last) { const CtxResid ce{X + (size_t)LAT * D, X + (size_t)LAT * D, modl + 2 * 9216 + 8 * 1024, 0.5f}; ctx_gemm(Hb + (size_t)LAT * DFF, WB + W_FO1, D, DFF, lds, bid, G, wave, lane, ce); }
        PH_END(pb + 13)
    }
    if (gridDim.x != 256) {
    PH_BEGIN(29)
        final_norm(X, args.in[I_FINALG], args.out, gw, NGW, lane);
    PH_END(29)
    }
#undef PH_BEGIN
#undef PH_END
#undef RUN_GEMM
}

#ifndef MK_MULTI
#define MK_MULTI 0
#endif
extern "C" void kernel_launch(void* const* d_in, const int* in_sizes, int n_in, void* d_out, int out_size, void* d_ws, size_t ws_size, hipStream_t stream) {
    static int grid = 0;
    if (grid == 0) {
        if (n_in != 17 || ws_size < WS_END) { fprintf(stderr, "kernel_launch: need 17 inputs and %zu bytes of workspace (got %d, %zu)\n", (size_t)WS_END, n_in, ws_size); grid = -1; return; }
        int dev = 0, cus = 0, per_cu = 0;
        hipGetDevice(&dev); hipDeviceGetAttribute(&cus, hipDeviceAttributeMultiprocessorCount, dev);
        if (hipFuncSetAttribute((const void*)fwd_mega, hipFuncAttributeMaxDynamicSharedMemorySize, LDS_BYTES) != hipSuccess) { fprintf(stderr, "kernel_launch: hipFuncSetAttribute failed\n"); grid = -1; return; }
        hipOccupancyMaxActiveBlocksPerMultiprocessor(&per_cu, (const void*)fwd_mega, NTHREADS, LDS_BYTES);
        if (per_cu < 1) { fprintf(stderr, "kernel_launch: occupancy query says %d blocks per CU\n", per_cu); per_cu = 1; }
        (void)hipGetLastError();
        grid = cus;
    }
    if (grid < 0) return;
    Args a{};
    for (int i = 0; i < 17; ++i) a.in[i] = (const float*)d_in[i];
    a.out = (float*)d_out; a.ws = (unsigned char*)d_ws;
    a.ph_lo = 0; a.ph_hi = (grid == 256) ? N_PHASES - 1 : N_PHASES;
    void* kargs[] = {&a};
    hipError_t e = hipLaunchCooperativeKernel((const void*)fwd_mega, dim3(grid), dim3(NTHREADS), kargs, LDS_BYTES, stream);
    if (e != hipSuccess) fprintf(stderr, "cooperative launch failed: %s (grid %d)\n", hipGetErrorString(e), grid);
}
```

```cpp
#include <hip/hip_runtime.h>
#include <hip/hip_cooperative_groups.h>
#include <cstdio>
#include <cstdint>
namespace cg = cooperative_groups;
namespace pg8 {
#define PG8_LAS __attribute__((address_space(3)))
typedef unsigned short bf16_t;
typedef short bf16x8 __attribute__((ext_vector_type(8)));
typedef float f32x4 __attribute__((ext_vector_type(4)));
typedef unsigned u32x4 __attribute__((ext_vector_type(4)));
constexpr int BM = 256, BK = 64, HALF = 128, HTB = HALF * BK * 2  , STAGE_BYTES = 8 * HTB, NXCD = 8, WGM = 8;

__host__ __device__ __forceinline__ int lds_byte(int r, int c) { const int st = (r >> 4) * 2 + (c >> 5), rr = r & 15, cc = c & 31, ob = rr * 64 + cc * 2; return st * 1024 + (ob ^ (((ob >> 9) & 1) << 5)); }
__host__ __device__ __forceinline__ void stage_rc(int b, int& R, int& C) { const int st = b / 1024, sb = b % 1024, swz = sb ^ (((sb >> 9) & 1) << 5); R = (st >> 1) * 16 + swz / 64; C = (st & 1) * 32 + (swz % 64) / 2; }
__host__ __device__ __forceinline__ int perm32(int rho) { const int n = rho >> 4, i = rho & 15; return 8 * (i >> 2) + 4 * n + (i & 3); }

struct Unit { int pm, pn; };
struct Gemm { const bf16_t* A; const bf16_t* Bt; int M, N, K; };

struct StaticOrder {
    int nM, nN, nwg, G, c;
    __host__ __device__ void init(int M, int N, int G_, int c_) { nM = M / BM; nN = N / BM; nwg = nM * nN; G = G_; c = c_; }
    __host__ __device__ bool next(int i, Unit& u) const {
        const long L = (long)i * G + c; if (L >= nwg) return false;
        int wgid = (int)L; { const int q = nwg / NXCD, r = nwg % NXCD, xcd = wgid % NXCD, off = wgid / NXCD; wgid = (xcd < r ? xcd * (q + 1) : r * (q + 1) + (xcd - r) * q) + off; }
        const int nig = WGM * nN, gid = wgid / nig, fm = gid * WGM, gsz = (nM - fm) < WGM ? (nM - fm) : WGM;
        u.pm = fm + ((wgid % nig) % gsz); u.pn = (wgid % nig) / gsz; return true;
    }
    __device__ __forceinline__ void a_ready(const Unit&) const {}
    __device__ __forceinline__ void done(const Unit&) const {}
};

typedef float f32x2_cv __attribute__((ext_vector_type(2))); typedef __bf16 bf16x2_cv __attribute__((ext_vector_type(2)));
__device__ __forceinline__ unsigned cvt_pk_bf16(float lo, float hi) { const f32x2_cv v = {lo, hi}; const bf16x2_cv b = __builtin_convertvector(v, bf16x2_cv); return __builtin_bit_cast(unsigned, b); }
typedef float f32x2 __attribute__((ext_vector_type(2)));
typedef struct { float x, y; } cs2_t;
typedef unsigned u32x2 __attribute__((ext_vector_type(2)));
__device__ __forceinline__ float sigm(float x) { return __builtin_amdgcn_rcpf(1.0f + __builtin_amdgcn_exp2f(-1.4426950408889634f * x)); }
__device__ __forceinline__ float bf2f(unsigned short h) { return __builtin_bit_cast(float, (unsigned)h << 16); }
constexpr int LATROWS = 16384, MTROWS = 16896, DFF = 2816;

struct EpiSwiGLU {
    static constexpr bool PERM = true, AFTER_DRAIN = false;
    bf16_t* H;
    __device__ __forceinline__ void operator()(const f32x4 (&acc)[2][2][4][2], const Unit& u, int wr, int wc, int fr, int fq) const {
        const int row0 = u.pm * BM + wr * 64 + fr, col0 = u.pn * 128 + wc * 32 + 8 * fq;
#pragma unroll
        for (int ai = 0; ai < 2; ++ai)
#pragma unroll
            for (int m = 0; m < 4; ++m) {
                bf16_t* p = H + (size_t)(row0 + ai * HALF + m * 16) * DFF + col0;
                const f32x4 a0 = acc[ai][0][m][0], a1 = acc[ai][0][m][1], b0 = acc[ai][1][m][0], b1 = acc[ai][1][m][1];
                float h[8];
#pragma unroll
                for (int j = 0; j < 4; ++j) { h[j] = a0[j] * sigm(a0[j]) * b0[j]; h[4 + j] = a1[j] * sigm(a1[j]) * b1[j]; }
                u32x4 w; w.x = cvt_pk_bf16(h[0], h[1]); w.y = cvt_pk_bf16(h[2], h[3]); w.z = cvt_pk_bf16(h[4], h[5]); w.w = cvt_pk_bf16(h[6], h[7]);
                *(u32x4*)p = w;
            }
    }
};
struct EpiResid {
    static constexpr bool PERM = false, AFTER_DRAIN = false;
    const float* base_lat; const float* base_ctx; float* out; const float* gate; float coef;
    __device__ __forceinline__ void operator()(const f32x4 (&acc)[2][2][4][2], const Unit& u, int wr, int wc, int fr, int fq) const {
        const int pm = u.pm; const bool lat = pm < 64; const int mb = lat ? (pm >> 5) : 2;
        const float* g = gate + mb * 9216;
        const float* brow = lat ? base_lat + (size_t)pm * 256 * 1024 : base_ctx + (size_t)(pm - 64) * 256 * 1024;
        float* orow = out + (size_t)pm * 256 * 1024;
        const int rl = wr * 64 + fr, col0 = u.pn * BM + wc * 32 + 4 * fq;
        f32x4 gv[2][2];
#pragma unroll
        for (int bj = 0; bj < 2; ++bj)
#pragma unroll
            for (int n = 0; n < 2; ++n) gv[bj][n] = *(const f32x4*)(g + col0 + bj * HALF + n * 16) * coef;
#pragma unroll
        for (int ai = 0; ai < 2; ++ai)
#pragma unroll
            for (int m = 0; m < 4; ++m) { const size_t off = (size_t)(rl + ai * HALF + m * 16) * 1024 + col0;
#pragma unroll
                for (int bj = 0; bj < 2; ++bj)
#pragma unroll
                    for (int n = 0; n < 2; ++n) { const f32x4 b = *(const f32x4*)(brow + off + bj * HALF + n * 16); *(f32x4*)(orow + off + bj * HALF + n * 16) = b + gv[bj][n] * acc[ai][bj][m][n]; }
                asm volatile("" ::: "memory"); }
    }
};
struct EpiQKVF {
    static constexpr bool PERM = false, AFTER_DRAIN = false;
    bf16_t *Q, *K, *V, *F; const cs2_t* rope;
    __device__ __forceinline__ void operator()(const f32x4 (&acc)[2][2][4][2], const Unit& u, int wr, int wc, int fr, int fq) const {
        const int pm = u.pm, pn = u.pn; const bool lat = pm < 64; const int type = pn < 4 ? 0 : (pn < 8 ? 1 : (pn < 12 ? 2 : 3));
        const float C2 = 0.125f * 1.4426950408889634f;
#pragma unroll
        for (int ai = 0; ai < 2; ++ai)
#pragma unroll
            for (int m = 0; m < 4; ++m) {
                const int row = pm * BM + ai * HALF + wr * 64 + m * 16 + fr;
                int kvrow, t;
                if (lat) { t = row & 8191; kvrow = (row >> 13) * 8448 + 256 + t; } else { const int r2 = row - LATROWS; t = r2 & 255; kvrow = (r2 >> 8) * 8448 + t; }
                const int pos = (wc & 1) ? (t & 63) : (t >> 6);
#pragma unroll
                for (int bj = 0; bj < 2; ++bj) {
                    f32x4 v0 = acc[ai][bj][m][0], v1 = acc[ai][bj][m][1];
                    if (type <= 1 && lat) {
#pragma unroll
                        for (int j = 0; j < 4; ++j) { const cs2_t cs = rope[pos * 16 + 4 * fq + j]; const float x1 = v0[j], x2 = v1[j]; v0[j] = x1 * cs.x - x2 * cs.y; v1[j] = x2 * cs.x + x1 * cs.y; }
                    }
                    const int col = (pn & 3) * BM + bj * HALF + wc * 32 + 4 * fq;
                    bf16_t* d;
                    if (type == 0) { v0 = v0 * C2; v1 = v1 * C2; d = Q + (size_t)row * 1024 + col; }
                    else if (type == 1) d = K + (size_t)kvrow * 1024 + col;
                    else if (type == 2) d = V + (size_t)kvrow * 1024 + col;
                    else d = F + (size_t)row * 512 + col;
                    u32x2 w0, w1; w0.x = cvt_pk_bf16(v0[0], v0[1]); w0.y = cvt_pk_bf16(v0[2], v0[3]); w1.x = cvt_pk_bf16(v1[0], v1[1]); w1.y = cvt_pk_bf16(v1[2], v1[3]);
                    *(u32x2*)d = w0; *(u32x2*)(d + 16) = w1;
                }
            }
    }
};
struct EpiGates {
    static constexpr bool PERM = true, AFTER_DRAIN = false;
    bf16_t* G; const float* bias;
    __device__ __forceinline__ void operator()(const f32x4 (&acc)[2][2][4][2], const Unit& u, int wr, int wc, int fr, int fq) const {
        const int row0 = u.pm * BM + wr * 64 + fr, col0 = u.pn * BM + wc * 32 + 8 * fq;
#pragma unroll
        for (int bj = 0; bj < 2; ++bj) {
            const f32x4 b0 = *(const f32x4*)(bias + col0 + bj * HALF), b1 = *(const f32x4*)(bias + col0 + bj * HALF + 4);
#pragma unroll
            for (int ai = 0; ai < 2; ++ai)
#pragma unroll
                for (int m = 0; m < 4; ++m) {
                    const f32x4 v0 = acc[ai][bj][m][0] + b0, v1 = acc[ai][bj][m][1] + b1;
                    u32x4 w; w.x = cvt_pk_bf16(sigm(v0[0]), sigm(v0[1])); w.y = cvt_pk_bf16(sigm(v0[2]), sigm(v0[3])); w.z = cvt_pk_bf16(sigm(v1[0]), sigm(v1[1])); w.w = cvt_pk_bf16(sigm(v1[2]), sigm(v1[3]));
                    *(u32x4*)(G + (size_t)(row0 + ai * HALF + m * 16) * 2048 + col0 + bj * HALF) = w;
                }
        }
    }
};
template <bool ADD> struct EpiGateMul {
    static constexpr bool PERM = true, AFTER_DRAIN = false;
    const bf16_t* G; bf16_t* MG; int goff;
    __device__ __forceinline__ void operator()(const f32x4 (&acc)[2][2][4][2], const Unit& u, int wr, int wc, int fr, int fq) const {
        const int row0 = u.pm * BM + wr * 64 + fr, col0 = u.pn * BM + wc * 32 + 8 * fq;
#pragma unroll
        for (int ai = 0; ai < 2; ++ai)
#pragma unroll
            for (int m = 0; m < 4; ++m)
#pragma unroll
                for (int bj = 0; bj < 2; ++bj) {
                    const size_t r = (size_t)(row0 + ai * HALF + m * 16); const int c = col0 + bj * HALF;
                    const u32x4 gw = *(const u32x4*)(G + r * 2048 + goff + c);
                    float o[8];
#pragma unroll
                    for (int j = 0; j < 4; ++j) { const unsigned gg = gw[j];
                        const float a0 = (j < 2) ? acc[ai][bj][m][0][2 * j] : acc[ai][bj][m][1][2 * j - 4], a1 = (j < 2) ? acc[ai][bj][m][0][2 * j + 1] : acc[ai][bj][m][1][2 * j - 3];
                        o[2 * j] = __builtin_bit_cast(float, gg << 16) * a0; o[2 * j + 1] = __builtin_bit_cast(float, gg & 0xffff0000u) * a1; }
                    bf16_t* p = MG + r * 1024 + c;
                    if (ADD) { const u32x4 pw = *(const u32x4*)p;
#pragma unroll
                        for (int j = 0; j < 4; ++j) { o[2 * j] += __builtin_bit_cast(float, pw[j] << 16); o[2 * j + 1] += __builtin_bit_cast(float, pw[j] & 0xffff0000u); } }
                    u32x4 w; w.x = cvt_pk_bf16(o[0], o[1]); w.y = cvt_pk_bf16(o[2], o[3]); w.z = cvt_pk_bf16(o[4], o[5]); w.w = cvt_pk_bf16(o[6], o[7]);
                    *(u32x4*)p = w;
                }
    }
};
struct EpiChanDFT {
    static constexpr bool PERM = false, AFTER_DRAIN = false;
    bf16_t* Z;
    __device__ __forceinline__ void operator()(const f32x4 (&acc)[2][2][4][2], const Unit& u, int wr, int wc, int fr, int fq) const {
        const int pm = u.pm; const bool lat = pm < 64;
#pragma unroll
        for (int ai = 0; ai < 2; ++ai)
#pragma unroll
            for (int m = 0; m < 4; ++m) {
                const int row = pm * BM + ai * HALF + wr * 64 + m * 16 + fr;
#pragma unroll
                for (int bj = 0; bj < 2; ++bj)
#pragma unroll
                    for (int n = 0; n < 2; ++n) {
                        const int chunk = u.pn * 64 + bj * 32 + wc * 8 + n * 4 + fq;
                        size_t off;
                        if (lat) off = ((size_t)((row >> 13) * 256 + chunk) * 8192 + (row & 8191)) * 4;
                        else { const int r2 = row - LATROWS; off = (size_t)LATROWS * 1024 + ((size_t)((r2 >> 8) * 256 + chunk) * 256 + (r2 & 255)) * 4; }
                        const f32x4 v = acc[ai][bj][m][n]; u32x2 w; w.x = cvt_pk_bf16(v[0], v[1]); w.y = cvt_pk_bf16(v[2], v[3]);
                        *(u32x2*)(Z + off) = w;
                    }
            }
    }
};

struct RmsExchange {
    unsigned* slots;
    unsigned* cnt;
    __device__ __forceinline__ void run(const f32x4 (&v)[2][2][4][2], const Unit& u, int wr, int wc, int fr, int fq, PG8_LAS unsigned char* lds, int wid, int lane) const {
        PG8_LAS float* P = (PG8_LAS float*)lds;
        PG8_LAS float* S = (PG8_LAS float*)(lds + 16384);
#pragma unroll
        for (int ai = 0; ai < 2; ++ai)
#pragma unroll
            for (int m = 0; m < 4; ++m) { float s = 0.f;
#pragma unroll
                for (int bj = 0; bj < 2; ++bj)
#pragma unroll
                    for (int n = 0; n < 2; ++n) { const f32x4 x = v[ai][bj][m][n]; s += (x[0] * x[0] + x[1] * x[1]) + (x[2] * x[2] + x[3] * x[3]); }
                P[(ai * HALF + wr * 64 + m * 16 + fr) * 16 + wc * 4 + fq] = s; }
        asm volatile("s_waitcnt lgkmcnt(0)" ::: "memory"); __builtin_amdgcn_s_barrier(); asm volatile("" ::: "memory");
        const int row = wid * 32 + (lane & 31);
        if (lane < 32) { float t = 0.f;
#pragma unroll
            for (int k = 0; k < 16; ++k) t += P[row * 16 + k];
            __hip_atomic_store(slots + (size_t)(u.pm * BM + row) * 4 + u.pn, __builtin_bit_cast(unsigned, t), __ATOMIC_RELAXED, __HIP_MEMORY_SCOPE_AGENT); }
        asm volatile("s_waitcnt vmcnt(0)" ::: "memory");
        if (lane == 0) __hip_atomic_fetch_add(cnt + 64 * u.pm, 1u, __ATOMIC_RELAXED, __HIP_MEMORY_SCOPE_AGENT);
        if (wid == 0) { unsigned sp = 0;
            while ((unsigned)__builtin_amdgcn_readfirstlane(__hip_atomic_load(cnt + 64 * u.pm, __ATOMIC_RELAXED, __HIP_MEMORY_SCOPE_AGENT)) < 32u) { __builtin_amdgcn_s_sleep(2); if (++sp > (1u << 22)) break; }
            __builtin_amdgcn_fence(__ATOMIC_ACQUIRE, "agent"); }
        asm volatile("s_waitcnt vmcnt(0) lgkmcnt(0)" ::: "memory"); __builtin_amdgcn_s_barrier(); asm volatile("" ::: "memory");
        if (lane < 32) { const unsigned* sl = slots + (size_t)(u.pm * BM + row) * 4; float t = 0.f;
#pragma unroll
            for (int k = 0; k < 4; ++k) t += __builtin_bit_cast(float, __hip_atomic_load(sl + k, __ATOMIC_RELAXED, __HIP_MEMORY_SCOPE_AGENT));
            S[row] = 1.0f / sqrtf(t * (1.0f / 1024.0f) + 1e-6f); }
        asm volatile("s_waitcnt lgkmcnt(0)" ::: "memory"); __builtin_amdgcn_s_barrier(); asm volatile("" ::: "memory");
    }
};
template <bool FINAL> struct EpiResidNorm {
    static constexpr bool PERM = false, AFTER_DRAIN = true;
    const float* base; float* X; const float* gate; float coef; const float* g; const float* mod; bf16_t* U; float* out; RmsExchange ex;
    __device__ __forceinline__ void fused(f32x4 (&acc)[2][2][4][2], const Unit& u, int wr, int wc, int fr, int fq, PG8_LAS unsigned char* lds, int wid, int lane) const {
        const int pm = u.pm, mb = pm >> 5; const float* gt = gate + mb * 9216;
        const int rl = wr * 64 + fr, col0 = u.pn * BM + wc * 32 + 4 * fq; const size_t rbase = (size_t)pm * 256 * 1024;
#pragma unroll
        for (int bj = 0; bj < 2; ++bj)
#pragma unroll
            for (int n = 0; n < 2; ++n) { const int col = col0 + bj * HALF + n * 16; const f32x4 gv = *(const f32x4*)(gt + col) * coef;
#pragma unroll
                for (int ai = 0; ai < 2; ++ai)
#pragma unroll
                    for (int m = 0; m < 4; ++m) { const size_t off = rbase + (size_t)(rl + ai * HALF + m * 16) * 1024 + col;
                        const f32x4 xn = *(const f32x4*)(base + off) + gv * acc[ai][bj][m][n]; acc[ai][bj][m][n] = xn; if (!FINAL) *(f32x4*)(X + off) = xn; }
                asm volatile("" ::: "memory"); }
        ex.run(acc, u, wr, wc, fr, fq, lds, wid, lane);
        const PG8_LAS float* S = (const PG8_LAS float*)(lds + 16384);
#pragma unroll
        for (int bj = 0; bj < 2; ++bj)
#pragma unroll
            for (int n = 0; n < 2; ++n) { const int col = col0 + bj * HALF + n * 16; const f32x4 gg = *(const f32x4*)(g + col);
                f32x4 sc, sh; if (!FINAL) { sh = *(const f32x4*)(mod + mb * 9216 + col); sc = *(const f32x4*)(mod + mb * 9216 + 1024 + col) + 1.0f; }
#pragma unroll
                for (int ai = 0; ai < 2; ++ai)
#pragma unroll
                    for (int m = 0; m < 4; ++m) { const int r = rl + ai * HALF + m * 16; const size_t off = rbase + (size_t)r * 1024 + col; const f32x4 y = acc[ai][bj][m][n] * S[r] * gg;
                        if (FINAL) *(f32x4*)(out + off) = y;
                        else { const f32x4 o = y * sc + sh; u32x2 w; w.x = cvt_pk_bf16(o[0], o[1]); w.y = cvt_pk_bf16(o[2], o[3]); *(u32x2*)(U + off) = w; } }
                asm volatile("" ::: "memory"); }
    }
};
template <class Epi, class Sched, bool ALIGN_EPI = false, bool SP2 = false>
__device__ __forceinline__ void gemm_phase(PG8_LAS unsigned char* lds, const Gemm g, const Sched& S, const Epi& E) {
    int tid = threadIdx.x; asm volatile("" : "+v"(tid));
    const int wid = __builtin_amdgcn_readfirstlane(tid >> 6), lane = tid & 63, wr = wid >> 2, wc = wid & 3, fr = lane & 15, fq = lane >> 4;
    const int K = g.K, nt = K / BK;
    unsigned voffA[2], voffB[2];
#pragma unroll
    for (int i = 0; i < 2; ++i) { int R, C; stage_rc(tid * 16 + i * 8192, R, C); const int Rb = Epi::PERM ? ((R & ~31) + perm32(R & 31)) : R;
        voffA[i] = (unsigned)(R * K + C) * 2u; voffB[i] = (unsigned)(Rb * K + C) * 2u; }
    const size_t kstep = (size_t)(BK * 2);
    const size_t hstep = (size_t)HALF * K * 2;
    const size_t tstep = 2 * hstep;
    const unsigned ldsw = (unsigned)wid * 1024u;
    const int aoff = lds_byte(wr * 64 + fr, fq * 8), boff = lds_byte(wc * 32 + fr, fq * 8);
#define PG8_SA(b, h) (((b) * 2 + (h)) * HTB)
#define PG8_SB(b, h) ((4 + (b) * 2 + (h)) * HTB)
#define PG8_STAGE(bufoff, gbase, voff) do { _Pragma("unroll") for (int _i = 0; _i < 2; ++_i) \
        __builtin_amdgcn_global_load_lds((const unsigned*)((const char*)(gbase) + (voff)[_i]), (PG8_LAS unsigned*)(lds + (bufoff) + ldsw + _i * 8192), 16, 0, 0); } while (0)
#define PG8_LDA(dst, b, h) do { _Pragma("unroll") for (int m = 0; m < 4; ++m) _Pragma("unroll") for (int k = 0; k < 2; ++k) dst[m][k] = *(const PG8_LAS bf16x8*)(lds + PG8_SA(b, h) + aoff + m * 2048 + k * 1024); } while (0)
#define PG8_LDB(dst, b, h) do { _Pragma("unroll") for (int n = 0; n < 2; ++n) _Pragma("unroll") for (int k = 0; k < 2; ++k) dst[n][k] = *(const PG8_LAS bf16x8*)(lds + PG8_SB(b, h) + boff + n * 2048 + k * 1024); } while (0)
#define PG8_MMA(ai, bj, At, Bt) do { __builtin_amdgcn_s_setprio(1); _Pragma("unroll") for (int m = 0; m < 4; ++m) _Pragma("unroll") for (int n = 0; n < 2; ++n) _Pragma("unroll") for (int k = 0; k < 2; ++k) \
        acc[ai][bj][m][n] = __builtin_amdgcn_mfma_f32_16x16x32_bf16(Bt[n][k], At[m][k], acc[ai][bj][m][n], 0, 0, 0); __builtin_amdgcn_s_setprio(0); } while (0)
#define PG8_WAIT_V(n) asm volatile("s_waitcnt vmcnt(" #n ")" ::: "memory")
#define PG8_WAIT_L(n) asm volatile("s_waitcnt lgkmcnt(" #n ")" ::: "memory")
#define PG8_BAR __builtin_amdgcn_s_barrier()
#define PG8_SCHED __builtin_amdgcn_sched_barrier(0)
    Unit cur, nxt; int ui = 0;
    if (!S.next(0, cur)) return;
    f32x4 acc[2][2][4][2];
#pragma unroll
    for (int a = 0; a < 2; ++a)
#pragma unroll
        for (int b = 0; b < 2; ++b)
#pragma unroll
            for (int m = 0; m < 4; ++m)
#pragma unroll
                for (int n = 0; n < 2; ++n) acc[a][b][m][n] = (f32x4){0.f, 0.f, 0.f, 0.f};
    bf16x8 At[4][2], B0[2][2], B1[2][2];
    const char* cA = (const char*)g.A + (size_t)cur.pm * tstep; const char* cB = (const char*)g.Bt + (size_t)cur.pn * tstep;
    S.a_ready(cur);
    if constexpr (SP2) {
        PG8_STAGE(PG8_SB(0, 0), cB, voffB); PG8_STAGE(PG8_SB(0, 1), cB + hstep, voffB); PG8_STAGE(PG8_SA(0, 0), cA, voffA); PG8_STAGE(PG8_SA(0, 1), cA + hstep, voffA);
        if (wr == 1) PG8_BAR;
        PG8_WAIT_V(2); PG8_BAR;
        PG8_STAGE(PG8_SB(1, 0), cB + kstep, voffB); PG8_STAGE(PG8_SA(1, 0), cA + kstep, voffA); PG8_STAGE(PG8_SB(1, 1), cB + hstep + kstep, voffB);
        PG8_WAIT_V(6); PG8_BAR;
    } else {
        PG8_STAGE(PG8_SB(0, 0), cB, voffB); PG8_STAGE(PG8_SA(0, 0), cA, voffA); PG8_STAGE(PG8_SB(0, 1), cB + hstep, voffB); PG8_STAGE(PG8_SA(0, 1), cA + hstep, voffA);
        if (wr == 1) PG8_BAR;
        PG8_WAIT_V(4); PG8_BAR;
        PG8_STAGE(PG8_SB(1, 0), cB + kstep, voffB); PG8_STAGE(PG8_SA(1, 0), cA + kstep, voffA); PG8_STAGE(PG8_SB(1, 1), cB + hstep + kstep, voffB);
        PG8_WAIT_V(6); PG8_BAR;
    }
    for (;;) {
        const bool has_next = S.next(ui + 1, nxt);
        const char* nA = has_next ? (const char*)g.A + (size_t)nxt.pm * tstep : cA; const char* nB = has_next ? (const char*)g.Bt + (size_t)nxt.pn * tstep : cB;
        for (int t = 0; t < nt; t += 2) {
            const bool last = (t == nt - 2);
            const char* a1 = cA + (size_t)(t + 1) * kstep;
            const char* a2 = last ? nA : cA + (size_t)(t + 2) * kstep; const char* b2 = last ? nB : cB + (size_t)(t + 2) * kstep;
            const char* a3 = a2 + kstep; const char* b3 = b2 + kstep;
            if (last && has_next) S.a_ready(nxt);
            if constexpr (SP2) {
            PG8_LDB(B0, 0, 0); PG8_LDB(B1, 0, 1); PG8_SCHED; PG8_LDA(At, 0, 0); PG8_STAGE(PG8_SA(1, 1), a1 + hstep, voffA);
            PG8_WAIT_V(8); PG8_WAIT_L(0); PG8_BAR; PG8_MMA(0, 0, At, B0); PG8_MMA(0, 1, At, B1); PG8_BAR; PG8_SCHED;
            PG8_LDA(At, 0, 1); PG8_STAGE(PG8_SB(0, 0), b2, voffB); PG8_STAGE(PG8_SB(0, 1), b2 + hstep, voffB); PG8_STAGE(PG8_SA(0, 0), a2, voffA);
            PG8_WAIT_V(8); PG8_WAIT_L(0); PG8_BAR; PG8_MMA(1, 0, At, B0); PG8_MMA(1, 1, At, B1); PG8_BAR; PG8_SCHED;
            PG8_LDB(B0, 1, 0); PG8_LDB(B1, 1, 1); PG8_SCHED; PG8_LDA(At, 1, 0); PG8_STAGE(PG8_SA(0, 1), a2 + hstep, voffA);
            PG8_WAIT_V(8); PG8_WAIT_L(0); PG8_BAR; PG8_MMA(0, 0, At, B0); PG8_MMA(0, 1, At, B1); PG8_BAR; PG8_SCHED;
            PG8_LDA(At, 1, 1); PG8_STAGE(PG8_SB(1, 0), b3, voffB); PG8_STAGE(PG8_SB(1, 1), b3 + hstep, voffB); PG8_STAGE(PG8_SA(1, 0), a3, voffA);
            PG8_WAIT_V(8); PG8_WAIT_L(0); PG8_BAR; PG8_MMA(1, 0, At, B0); PG8_MMA(1, 1, At, B1); PG8_BAR; PG8_SCHED;
            } else {
            PG8_LDB(B0, 0, 0); PG8_SCHED; PG8_LDA(At, 0, 0); PG8_STAGE(PG8_SA(1, 1), a1 + hstep, voffA);
            PG8_WAIT_L(8); PG8_BAR; PG8_WAIT_L(0); PG8_MMA(0, 0, At, B0); PG8_BAR; PG8_SCHED;
            PG8_LDB(B1, 0, 1); PG8_STAGE(PG8_SB(0, 0), b2, voffB);
            PG8_BAR; PG8_WAIT_L(0); PG8_MMA(0, 1, At, B1); PG8_BAR;
            PG8_LDA(At, 0, 1); PG8_STAGE(PG8_SA(0, 0), a2, voffA);
            PG8_BAR; PG8_WAIT_L(0); PG8_MMA(1, 0, At, B0); PG8_BAR; PG8_SCHED;
            PG8_STAGE(PG8_SB(0, 1), b2 + hstep, voffB);
            PG8_WAIT_V(6); PG8_BAR; PG8_MMA(1, 1, At, B1); PG8_BAR;
            PG8_LDB(B0, 1, 0); PG8_SCHED; PG8_LDA(At, 1, 0); PG8_STAGE(PG8_SA(0, 1), a2 + hstep, voffA);
            PG8_WAIT_L(8); PG8_BAR; PG8_WAIT_L(0); PG8_MMA(0, 0, At, B0); PG8_BAR; PG8_SCHED;
            PG8_LDB(B1, 1, 1); PG8_STAGE(PG8_SB(1, 0), b3, voffB);
            PG8_BAR; PG8_WAIT_L(0); PG8_MMA(0, 1, At, B1); PG8_BAR;
            PG8_LDA(At, 1, 1); PG8_STAGE(PG8_SA(1, 0), a3, voffA);
            PG8_BAR; PG8_WAIT_L(0); PG8_MMA(1, 0, At, B0); PG8_BAR; PG8_SCHED;
            PG8_STAGE(PG8_SB(1, 1), b3 + hstep, voffB);
            PG8_WAIT_V(6); PG8_BAR; PG8_MMA(1, 1, At, B1); PG8_BAR;
            }
        }
        if constexpr (ALIGN_EPI) { if (wr == 0) PG8_BAR; }
        if constexpr (!Epi::AFTER_DRAIN) { E(acc, cur, wr, wc, fr, fq); S.done(cur); }
        if (!has_next) break;
#pragma unroll
        for (int a = 0; a < 2; ++a)
#pragma unroll
            for (int b = 0; b < 2; ++b)
#pragma unroll
                for (int m = 0; m < 4; ++m)
#pragma unroll
                    for (int n = 0; n < 2; ++n) acc[a][b][m][n] = (f32x4){0.f, 0.f, 0.f, 0.f};
        cur = nxt; cA = nA; cB = nB; ++ui;
        if constexpr (ALIGN_EPI) { if (wr == 1) PG8_BAR; }
    }
    PG8_WAIT_V(0);
    if constexpr (!ALIGN_EPI) { if (wr == 0) PG8_BAR; }
    PG8_BAR;
    if constexpr (Epi::AFTER_DRAIN) { E.fused(acc, cur, wr, wc, fr, fq, lds, wid, lane); S.done(cur); }
#undef PG8_SA
#undef PG8_SB
#undef PG8_STAGE
#undef PG8_LDA
#undef PG8_LDB
#undef PG8_MMA
#undef PG8_WAIT_V
#undef PG8_WAIT_L
#undef PG8_BAR
#undef PG8_SCHED
}
}
#include <hip/hip_bf16.h>
#include <cmath>
namespace attn_body {
using bf16=__hip_bfloat16;
using bf16x8=__attribute__((ext_vector_type(8)))short;
using s16x4=__attribute__((ext_vector_type(4)))short;
using f32x16=__attribute__((ext_vector_type(16)))float;
using u32x4=__attribute__((ext_vector_type(4)))unsigned;
constexpr int D=64,DM=1024;
constexpr int NW=8,QBLK=32,QB=QBLK*NW,KVBLK=64;
constexpr int ATTN_PITCH=DM, ATTN_UNIT_ROWS=QB;
__device__ __forceinline__ int crow(int r,int hi){return (r&3)+8*(r>>2)+4*hi;}
#define SBAR() __builtin_amdgcn_sched_barrier(0)
__device__ __forceinline__ void cmask(f32x16&p0,f32x16&p1,int jb,int qrel,int hi){
  const float NEG=-INFINITY; int kb=64*jb+4*hi;
  #pragma unroll
  for(int r=0;r<16;++r){int kv=kb+(r&3)+8*(r>>2); if(kv>qrel)p0[r]=NEG; if(kv+32>qrel)p1[r]=NEG;}
}

constexpr int NSLOT=3, SLOTB=8192;
constexpr int LDS_K=0, LDS_V=NSLOT*SLOTB, LDS_WS=3*NSLOT*SLOTB, LDS_OST=LDS_WS+NW*64*4, LDS_BYTES=LDS_OST+NW*4096;
constexpr float C2=0.125f*1.4426950408889634f;
__device__ __forceinline__ void glds16(const void*gsrc,unsigned lds_dst){unsigned keep;
  asm volatile("s_mov_b32 %0, m0\n\ts_mov_b32 m0, %2\n\ts_nop 0\n\tglobal_load_lds_dwordx4 %1, off\n\ts_mov_b32 m0, %0":"=&s"(keep):"v"(gsrc),"s"(lds_dst):"memory");}
__device__ __forceinline__ float max3f(float a,float b,float c){float r;asm("v_max3_f32 %0, %1, %2, %3":"=v"(r):"v"(a),"v"(b),"v"(c));return r;}
__device__ __forceinline__ float max2f(float a,float b){float r;asm("v_max_f32_e32 %0, %1, %2":"=v"(r):"v"(a),"v"(b));return r;}
__device__ __forceinline__ float fadd_s(float a,float b){float r;asm("v_add_f32_e32 %0, %1, %2":"=v"(r):"v"(a),"v"(b));return r;}
__device__ __forceinline__ float fsub_s(float a,float b){float r;asm("v_sub_f32_e32 %0, %1, %2":"=v"(r):"v"(a),"v"(b));return r;}
typedef float f32x2_t __attribute__((ext_vector_type(2))); typedef __bf16 bf16x2_t __attribute__((ext_vector_type(2)));
__device__ __forceinline__ unsigned cvtpk_s(float lo,float hi){f32x2_t v={lo,hi};bf16x2_t b=__builtin_convertvector(v,bf16x2_t);return __builtin_bit_cast(unsigned,b);}
#define WAIT_BAR(N) asm volatile("s_waitcnt vmcnt(" #N ") lgkmcnt(0)\n\ts_barrier":::"memory")

__device__ __forceinline__ void qkt(f32x16&p0,f32x16&p1,const char*Kslot,const bf16x8*qr,const f32x16&negm,int r32,int hi){
  const char*kb=Kslot+hi*1024+r32*16;
  #pragma unroll
  for(int d0=0;d0<4;++d0){
    const bf16x8 b0=*reinterpret_cast<const bf16x8*>(kb+d0*2048);
    const bf16x8 b1=*reinterpret_cast<const bf16x8*>(kb+d0*2048+512);
    if(d0==0){p0=__builtin_amdgcn_mfma_f32_32x32x16_bf16(b0,qr[0],negm,0,0,0);p1=__builtin_amdgcn_mfma_f32_32x32x16_bf16(b1,qr[0],negm,0,0,0);}
    else{p0=__builtin_amdgcn_mfma_f32_32x32x16_bf16(b0,qr[d0],p0,0,0,0);p1=__builtin_amdgcn_mfma_f32_32x32x16_bf16(b1,qr[d0],p1,0,0,0);}}
}
typedef __attribute__((address_space(3))) const char* lds_cptr;
typedef short v4i16_t __attribute__((ext_vector_type(4)));
__device__ __forceinline__ void kload8(bf16x8*kf,lds_cptr kp){
  kf[0]=*(const __attribute__((address_space(3))) bf16x8*)(kp);      kf[1]=*(const __attribute__((address_space(3))) bf16x8*)(kp+512);
  kf[2]=*(const __attribute__((address_space(3))) bf16x8*)(kp+2048); kf[3]=*(const __attribute__((address_space(3))) bf16x8*)(kp+2560);
  kf[4]=*(const __attribute__((address_space(3))) bf16x8*)(kp+4096); kf[5]=*(const __attribute__((address_space(3))) bf16x8*)(kp+4608);
  kf[6]=*(const __attribute__((address_space(3))) bf16x8*)(kp+6144); kf[7]=*(const __attribute__((address_space(3))) bf16x8*)(kp+6656);
}
__device__ __forceinline__ void kload2(bf16x8*kf,lds_cptr kp,int j){ kf[2*j]=*(const __attribute__((address_space(3))) bf16x8*)(kp+j*2048); kf[2*j+1]=*(const __attribute__((address_space(3))) bf16x8*)(kp+j*2048+512); }
__device__ __forceinline__ s16x4 vtr(lds_cptr p){ return __builtin_bit_cast(s16x4,__builtin_amdgcn_ds_read_tr16_b64_v4i16((__attribute__((address_space(3))) v4i16_t*)p)); }
__device__ __forceinline__ float rowmax(const f32x16&p0,const f32x16&p1){
  float a=max3f(p0[0],p0[1],p1[0]),b=max3f(p0[2],p0[3],p1[1]);a=max3f(a,p1[2],p1[3]);
  #pragma unroll
  for(int r=4;r<16;r+=4){a=max3f(a,p0[r],p0[r+1]);b=max3f(b,p0[r+2],p0[r+3]);a=max3f(a,p1[r],p1[r+1]);b=max3f(b,p1[r+2],p1[r+3]);}
  const float m=max2f(a,b);
  auto rr=__builtin_amdgcn_permlane32_swap(__float_as_uint(m),__float_as_uint(m),false,false);
  return max2f(__uint_as_float(rr[0]),__uint_as_float(rr[1]));
}
__device__ __forceinline__ void pv(f32x16*o,int vb,bf16x8 pa0,bf16x8 pa1,bf16x8 pa2,bf16x8 pa3){
  #pragma unroll
  for(int d0=0;d0<2;++d0){s16x4 lo[4],hi[4];
    #pragma unroll
    for(int ks=0;ks<4;++ks){
      asm volatile("ds_read_b64_tr_b16 %0,%1 offset:%c2":"=&v"(lo[ks]):"v"(vb),"i"(d0*4096+ks*1024):"memory");
      asm volatile("ds_read_b64_tr_b16 %0,%1 offset:%c2":"=&v"(hi[ks]):"v"(vb),"i"(d0*4096+ks*1024+512):"memory");}
    asm volatile("s_waitcnt lgkmcnt(0)":::"memory");SBAR();
    #define PK(k) (bf16x8){lo[k][0],lo[k][1],lo[k][2],lo[k][3],hi[k][0],hi[k][1],hi[k][2],hi[k][3]}
    o[d0]=__builtin_amdgcn_mfma_f32_32x32x16_bf16(pa0,PK(0),o[d0],0,0,0);
    o[d0]=__builtin_amdgcn_mfma_f32_32x32x16_bf16(pa1,PK(1),o[d0],0,0,0);
    o[d0]=__builtin_amdgcn_mfma_f32_32x32x16_bf16(pa2,PK(2),o[d0],0,0,0);
    o[d0]=__builtin_amdgcn_mfma_f32_32x32x16_bf16(pa3,PK(3),o[d0],0,0,0);
    #undef PK
  }
}

#ifndef ATTN_STORE16
#define ATTN_STORE16(p,v) (*(u32x4*)(p)=(v))
#endif
template<int THRL> __device__ __forceinline__ void attn_unit(const bf16*Qu,const bf16*__restrict__ Kh,const bf16*__restrict__ Vh,bf16*Ou,const int NT,char*shm){
  int tid=threadIdx.x; asm volatile("":"+v"(tid)); const int lane=tid&63,r32=lane&31,hi=lane>>5; const int wid=__builtin_amdgcn_readfirstlane(tid>>6);
  const bf16*Qw=Qu+(long)(wid*QBLK)*DM;
  const unsigned lds0=(unsigned)(uintptr_t)shm;
  float*wsf=(float*)(shm+LDS_WS)+wid*64;
  const bf16*ksrc=Kh+(long)lane*DM+wid*8;
  const bf16*vsrc=Vh+(long)(16*(wid&3)+(lane>>2))*DM+(wid>>2)*32+(lane&3)*8;
  const unsigned kdst=lds0+LDS_K+wid*1024, vdst=lds0+LDS_V+wid*1024;
  #define DMA_K(t,slot) glds16(ksrc+(long)(t)*KVBLK*DM,(unsigned)__builtin_amdgcn_readfirstlane(kdst+(slot)))
  #define DMA_V(t,slot) do{ glds16(vsrc+(long)(t)*KVBLK*DM,(unsigned)__builtin_amdgcn_readfirstlane(vdst+2*(slot))); glds16(vsrc+64+(long)(t)*KVBLK*DM,(unsigned)__builtin_amdgcn_readfirstlane(vdst+2*(slot)+SLOTB)); }while(0)
  const int vb0=(int)(lds0+LDS_V)+((lane>>4)&1)*32+(lane&3)*8+(4*hi+((lane&15)>>2))*64;
  const char*Kbase=shm+LDS_K; bf16x8 kf[8];
  const lds_cptr shm3=(lds_cptr)shm; const lds_cptr kp0=shm3+LDS_K+hi*1024+r32*16; const lds_cptr vp0=shm3+LDS_V+((lane>>4)&1)*32+(lane&3)*8+(4*hi+((lane&15)>>2))*64;
  DMA_K(0,0);DMA_V(0,0);DMA_K(1,SLOTB);
  bf16x8 qr[4];
  #pragma unroll
  for(int d0=0;d0<4;++d0)qr[d0]=*reinterpret_cast<const bf16x8*>(&Qw[(long)r32*DM+d0*16+hi*8]);
  float mhat=0.f,l_reg=0.f;f32x16 o[4];o[0]=f32x16{};o[1]=f32x16{};o[2]=f32x16{};o[3]=f32x16{};const f32x16 z16=f32x16{};
  #define CMASK(P0,P1,t) do{}while(0)
  bool resc=false;
  #define START(P0,P1) do{ const float rm=rowmax(P0,P1); resc=false; \
    { const float dl=rm; mhat=fadd_s(mhat,dl); \
      _Pragma("unroll") for(int r=0;r<16;++r){P0[r]=fsub_s(P0[r],dl);P1[r]=fsub_s(P1[r],dl);} \
      } \
    _Pragma("unroll") for(int r=0;r<16;++r)P0[r]=__builtin_amdgcn_exp2f(P0[r]); }while(0)
  #define RESC() do{ if(resc){ asm volatile("s_waitcnt lgkmcnt(0)":::"memory"); \
      _Pragma("unroll") for(int d_=0;d_<4;++d_) _Pragma("unroll") for(int r=0;r<16;++r)o[d_][r]*=wsf[crow(r,hi)]; } }while(0)
  f32x16 pA0,pA1,pB0,pB1;
  int sl_prev=0,sl_cur=0,sl_next=SLOTB;
  #define ROT() do{sl_prev=sl_cur;sl_cur=sl_next;sl_next=(sl_next==(NSLOT-1)*SLOTB)?0:sl_next+SLOTB;}while(0)
  DMA_K(2,2*SLOTB);
  WAIT_BAR(4);
  qkt(pA0,pA1,Kbase,qr,z16,r32,hi);asm volatile("s_nop 15\n\ts_nop 7":"+v"(pA0),"+v"(pA1));CMASK(pA0,pA1,0);
  START(pA0,pA1);
  _Pragma("unroll") for(int r=0;r<16;++r)pA1[r]=__builtin_amdgcn_exp2f(pA1[r]);
  WAIT_BAR(0);
  DMA_K(3,0);DMA_V(1,SLOTB);
  ROT();
  kload8(kf,kp0+sl_cur);
  WAIT_BAR(3);
  s16x4 vlo[8],vhi[8]; u32x4 pw0,pw1,pw2,pw3;
  #define PKW(P,B) cvtpk_s(P[B],P[B+1])
  #define PAF(k) __builtin_bit_cast(bf16x8,pw##k)
  #define VFR(i) (bf16x8){vlo[i][0],vlo[i][1],vlo[i][2],vlo[i][3],vhi[i][0],vhi[i][1],vhi[i][2],vhi[i][3]}
  #define PIN(x) asm volatile("":"+v"(x))
  #define MX3(a,b,c) __builtin_fmaxf(__builtin_fmaxf((a),(b)),(c))
  #define GAPA(MF,A0,A1,A2,A3,W0,W1,PW) do{ MF; sacc+=A0; sacc+=A1; sacc+=A2; sacc+=A3; PIN(sacc); W0; W1; PIN(PW); SBAR(); }while(0)
  #define EX(v) __builtin_amdgcn_exp2f(v)
  #define GAPB(MF,X,B) do{ MF; X[B]=EX(X[B]); X[B+1]=EX(X[B+1]); X[B+2]=EX(X[B+2]); X[B+3]=EX(X[B+3]); PIN(X); SBAR(); }while(0)
  #define VRD(i) do{ vlo[i]=vtr(vp_+(((i)>>2)*4096+((i)&3)*1024)); vhi[i]=vtr(vp_+(((i)>>2)*4096+((i)&3)*1024+512)); }while(0)
  #define VRD2(i) do{ vlo[i]=vtr(vp_+(8192+((i)>>2)*4096+((i)&3)*1024)); vhi[i]=vtr(vp_+(8192+((i)>>2)*4096+((i)&3)*1024+512)); }while(0)
  #define KRD(G,j) do{ if(G){ kload2(kf,kp0+sl_next,j); SBAR(); } }while(0)
  #define STEP(C0,C1,P0,P1,t,GK,GV,GL) do{ SBAR(); \
    const lds_cptr vp_=vp0+2*sl_prev; \
    __builtin_amdgcn_s_setprio(1); VRD(0); SBAR(); float sacc=(P0[0]+P0[1]); \
    GAPA(C0=__builtin_amdgcn_mfma_f32_32x32x16_bf16(kf[0],qr[0],z16,0,0,0), P0[2],P0[3],P0[4],P0[5],     pw0[0]=PKW(P0,0), pw0[1]=PKW(P0,2), pw0); \
    VRD(4); SBAR(); GAPA(C1=__builtin_amdgcn_mfma_f32_32x32x16_bf16(kf[1],qr[0],z16,0,0,0), P0[6],P0[7],P0[8],P0[9],     pw0[2]=PKW(P0,4), pw0[3]=PKW(P0,6), pw0); \
    VRD(1); SBAR(); GAPA(C0=__builtin_amdgcn_mfma_f32_32x32x16_bf16(kf[2],qr[1],C0,0,0,0),   P0[10],P0[11],P0[12],P0[13], pw1[0]=PKW(P0,8), pw1[1]=PKW(P0,10), pw1); \
    VRD(5); SBAR(); GAPA(C1=__builtin_amdgcn_mfma_f32_32x32x16_bf16(kf[3],qr[1],C1,0,0,0),   P0[14],P0[15],P1[0],P1[1],   pw1[2]=PKW(P0,12),pw1[3]=PKW(P0,14), pw1); \
    VRD(2); SBAR(); GAPA(C0=__builtin_amdgcn_mfma_f32_32x32x16_bf16(kf[4],qr[2],C0,0,0,0),   P1[2],P1[3],P1[4],P1[5],     pw2[0]=PKW(P1,0), pw2[1]=PKW(P1,2), pw2); \
    VRD(6); SBAR(); GAPA(C1=__builtin_amdgcn_mfma_f32_32x32x16_bf16(kf[5],qr[2],C1,0,0,0),   P1[6],P1[7],P1[8],P1[9],     pw2[2]=PKW(P1,4), pw2[3]=PKW(P1,6), pw2); \
    VRD(3); SBAR(); GAPA(C0=__builtin_amdgcn_mfma_f32_32x32x16_bf16(kf[6],qr[3],C0,0,0,0),   P1[10],P1[11],P1[12],P1[13], pw3[0]=PKW(P1,8), pw3[1]=PKW(P1,10), pw3); \
    VRD(7); SBAR(); GAPA(C1=__builtin_amdgcn_mfma_f32_32x32x16_bf16(kf[7],qr[3],C1,0,0,0),   P1[14],P1[15],0.f,0.f,       pw3[2]=PKW(P1,12),pw3[3]=PKW(P1,14), pw3); \
    l_reg+=sacc; __builtin_amdgcn_s_setprio(0); \
    if(GK){DMA_K((t)+3,sl_cur);} if(GV){DMA_V((t)+1,sl_next);} \
    _Pragma("unroll") for(int r=0;r<16;++r){C0[r]-=mhat;C1[r]-=mhat;} \
    CMASK(C0,C1,t); \
    { float a=MX3(C0[0],C0[1],C1[0]),b=MX3(C0[2],C0[3],C1[1]); a=MX3(a,C1[2],C1[3]); \
      _Pragma("unroll") for(int r=4;r<16;r+=4){a=MX3(a,C0[r],C0[r+1]);b=MX3(b,C0[r+2],C0[r+3]);a=MX3(a,C1[r],C1[r+1]);b=MX3(b,C1[r+2],C1[r+3]);} \
      float rm=__builtin_fmaxf(a,b); { auto rr=__builtin_amdgcn_permlane32_swap(__float_as_uint(rm),__float_as_uint(rm),false,false); rm=__builtin_fmaxf(__uint_as_float(rr[0]),__uint_as_float(rr[1])); } \
      resc=false; \
      if(__builtin_expect(__any(rm>(float)THRL),0)){ const float dl=__builtin_fmaxf(rm,0.f); mhat+=dl; \
        _Pragma("unroll") for(int r=0;r<16;++r){C0[r]-=dl;C1[r]-=dl;} \
        const float f=__builtin_amdgcn_exp2f(-dl); l_reg*=f; if(hi==0)wsf[r32]=f; resc=true; } } \
    __builtin_amdgcn_s_setprio(1); SBAR(); \
    GAPB(o[0]=__builtin_amdgcn_mfma_f32_32x32x16_bf16(PAF(0),VFR(0),o[0],0,0,0), C0,0); \
    GAPB(o[1]=__builtin_amdgcn_mfma_f32_32x32x16_bf16(PAF(0),VFR(4),o[1],0,0,0), C0,4); \
    KRD(GL,0); GAPB(o[0]=__builtin_amdgcn_mfma_f32_32x32x16_bf16(PAF(1),VFR(1),o[0],0,0,0), C0,8); \
    KRD(GL,1); GAPB(o[1]=__builtin_amdgcn_mfma_f32_32x32x16_bf16(PAF(1),VFR(5),o[1],0,0,0), C0,12); \
    KRD(GL,2); GAPB(o[0]=__builtin_amdgcn_mfma_f32_32x32x16_bf16(PAF(2),VFR(2),o[0],0,0,0), C1,0); \
    KRD(GL,3); GAPB(o[1]=__builtin_amdgcn_mfma_f32_32x32x16_bf16(PAF(2),VFR(6),o[1],0,0,0), C1,4); \
    GAPB(o[0]=__builtin_amdgcn_mfma_f32_32x32x16_bf16(PAF(3),VFR(3),o[0],0,0,0), C1,8); \
    GAPB(o[1]=__builtin_amdgcn_mfma_f32_32x32x16_bf16(PAF(3),VFR(7),o[1],0,0,0), C1,12); \
    VRD2(0); VRD2(4); VRD2(1); VRD2(5); SBAR(); \
    o[2]=__builtin_amdgcn_mfma_f32_32x32x16_bf16(PAF(0),VFR(0),o[2],0,0,0); o[3]=__builtin_amdgcn_mfma_f32_32x32x16_bf16(PAF(0),VFR(4),o[3],0,0,0); VRD2(2); VRD2(6); SBAR(); \
    o[2]=__builtin_amdgcn_mfma_f32_32x32x16_bf16(PAF(1),VFR(1),o[2],0,0,0); o[3]=__builtin_amdgcn_mfma_f32_32x32x16_bf16(PAF(1),VFR(5),o[3],0,0,0); VRD2(3); VRD2(7); SBAR(); \
    o[2]=__builtin_amdgcn_mfma_f32_32x32x16_bf16(PAF(2),VFR(2),o[2],0,0,0); o[3]=__builtin_amdgcn_mfma_f32_32x32x16_bf16(PAF(2),VFR(6),o[3],0,0,0); SBAR(); \
    o[2]=__builtin_amdgcn_mfma_f32_32x32x16_bf16(PAF(3),VFR(3),o[2],0,0,0); o[3]=__builtin_amdgcn_mfma_f32_32x32x16_bf16(PAF(3),VFR(7),o[3],0,0,0); __builtin_amdgcn_s_setprio(0); SBAR(); \
    }while(0)
  int t=1;
  #undef CMASK
  #define CMASK(P0,P1,t) do{}while(0)
  for(;t+5<NT;t+=2){
    STEP(pB0,pB1,pA0,pA1,t,true,true,true);     WAIT_BAR(3); RESC(); ROT();
    STEP(pA0,pA1,pB0,pB1,t+1,true,true,true);   WAIT_BAR(3); RESC(); ROT();
  }
  #undef CMASK
  #define CMASK(P0,P1,t) do{}while(0)
  #define ENDW(tt) do{ if((tt)+3<NT){WAIT_BAR(3);} else if((tt)+2<NT){WAIT_BAR(2);} else {WAIT_BAR(0);} }while(0)
  for(;t+1<NT;t+=2){
    STEP(pB0,pB1,pA0,pA1,t,(t+3<NT),(t+1<NT),(t+1<NT));       ENDW(t);   RESC(); ROT();
    STEP(pA0,pA1,pB0,pB1,t+1,(t+4<NT),(t+2<NT),(t+2<NT));     ENDW(t+1); RESC(); ROT();
  }
  STEP(pB0,pB1,pA0,pA1,NT-1,false,false,false); RESC();
  { float sacc=pB0[0]+pB0[1]; _Pragma("unroll") for(int r=2;r<16;++r)sacc+=pB0[r]; _Pragma("unroll") for(int r=0;r<16;++r)sacc+=pB1[r]; l_reg+=sacc;
    pw0=(u32x4){PKW(pB0,0),PKW(pB0,2),PKW(pB0,4),PKW(pB0,6)};pw1=(u32x4){PKW(pB0,8),PKW(pB0,10),PKW(pB0,12),PKW(pB0,14)};pw2=(u32x4){PKW(pB1,0),PKW(pB1,2),PKW(pB1,4),PKW(pB1,6)};pw3=(u32x4){PKW(pB1,8),PKW(pB1,10),PKW(pB1,12),PKW(pB1,14)};
    SBAR(); pv(o,vb0+2*sl_cur,PAF(0),PAF(1),PAF(2),PAF(3)); pv(o+2,vb0+2*sl_cur+SLOTB,PAF(0),PAF(1),PAF(2),PAF(3)); }
  #undef PKW
  #undef PAF
  #undef VFR
  #undef PIN
  #undef MX3
  #undef GAPA
  #undef GAPB
  #undef EX
  #undef VRD
  #undef VRD2
  #undef KRD
  #undef STEP
  #undef ENDW
  {auto rr=__builtin_amdgcn_permlane32_swap(__float_as_uint(l_reg),__float_as_uint(l_reg),false,false);l_reg=__uint_as_float(rr[0])+__uint_as_float(rr[1]);}
  if(hi==0)wsf[32+r32]=l_reg;asm volatile("s_waitcnt lgkmcnt(0)":::"memory");
  float rli[16];
  #pragma unroll
  for(int r=0;r<16;++r)rli[r]=__builtin_amdgcn_rcpf(wsf[32+crow(r,hi)]);
  bf16*Ow=Ou+(long)(wid*QBLK)*DM;
  { bf16*stg=(bf16*)(shm+LDS_OST)+wid*2048;
    #pragma unroll
    for(int hv=0;hv<2;++hv){
      #pragma unroll
      for(int r=0;r<16;++r){const int orow=crow(r,hi);
        #pragma unroll
        for(int d0=0;d0<2;++d0)stg[orow*64+d0*32+r32]=__float2bfloat16(o[2*hv+d0][r]*rli[r]);}
      asm volatile("s_waitcnt lgkmcnt(0)":::"memory");
      #pragma unroll
      for(int i=0;i<4;++i){const int row=i*8+(lane>>3),ch=lane&7; const u32x4 v=*(const u32x4*)(stg+row*64+ch*8); ATTN_STORE16(Ow+(long)row*DM+hv*64+ch*8,v);}
      asm volatile("s_waitcnt lgkmcnt(0)":::"memory"); } }
  asm volatile("s_waitcnt lgkmcnt(0)\n\ts_barrier":::"memory");
  #undef DMA_K
  #undef DMA_V
  #undef CMASK
  #undef START
  #undef RESC
  #undef ROT
}
constexpr int ATTN_LDS_BYTES=LDS_BYTES;
#undef SBAR
#undef WAIT_BAR
}
constexpr int NWAVES = 8, NTHREADS = 512;
constexpr int D = 1024, SEQ = 8192, CTXL = 256, LAT = 16384, MT = 16896, NCTX = 512, DFF = 2816, INW = 5632;
constexpr float EPS = 1e-6f;
constexpr size_t MiB = 1u << 20;
constexpr size_t WS_MOD = 0;
constexpr size_t WS_LAM = 256 * 1024;
constexpr size_t WS_ROPE = 288 * 1024;
constexpr size_t WS_TW8192 = 320 * 1024;
constexpr size_t WS_TW256 = 384 * 1024;
constexpr size_t WS_CNT = 480 * 1024;
constexpr size_t WS_WB = 512 * 1024;
constexpr size_t WS_WC = 640 * 1024;
constexpr size_t WS_WBD = 1 * MiB;
constexpr size_t WS_W = 2 * MiB;
constexpr size_t W_FI0 = 0, W_FI1 = 5767168, W_FO0 = 11534336, W_FO1 = 14417920, W_IN = 17301504, W_AO = 23068672, W_FR = 24117248, W_O = 24641536;
constexpr size_t WS_X = 51 * MiB;
constexpr size_t WS_U = 117 * MiB;
constexpr size_t WS_R = 150 * MiB;
constexpr size_t WS_Q = WS_R, WS_K = WS_R + 33 * MiB, WS_V = WS_R + 66 * MiB, WS_F = WS_R + 99 * MiB, WS_O0 = WS_F + 33 * MiB / 2, WS_O1 = WS_O0 + 33 * MiB;
constexpr size_t WS_H = WS_R, WS_Z = WS_Q, WS_G = WS_K, WS_FM = WS_F, WS_MG = WS_O1;
constexpr size_t WS_FMC = WS_O1 + 33 * MiB;
constexpr size_t WS_SLOTS = WS_FMC + 2 * MiB;
constexpr size_t WS_END = WS_FMC + 16 * MiB;
constexpr int LDS_BYTES = 147456;

#define LAS __attribute__((address_space(3)))
typedef unsigned short bf16;
typedef unsigned v4u __attribute__((ext_vector_type(4)));
typedef float f32x4 __attribute__((ext_vector_type(4)));
typedef float f32x16 __attribute__((ext_vector_type(16)));
typedef short bf16x8 __attribute__((ext_vector_type(8)));
typedef pg8::cs2_t cs2;
__device__ __forceinline__ unsigned f2bf(float f) { unsigned u = __builtin_bit_cast(unsigned, f); return (u + 0x7fffu + ((u >> 16) & 1u)) >> 16; }
__device__ __forceinline__ unsigned pk2(float lo, float hi) { return f2bf(lo) | (f2bf(hi) << 16); }
__device__ __forceinline__ float blo(unsigned w) { return __builtin_bit_cast(float, w << 16); }
__device__ __forceinline__ float bhi(unsigned w) { return __builtin_bit_cast(float, w & 0xffff0000u); }
template <int M> __device__ __forceinline__ float swz_xor(float v) { return __builtin_bit_cast(float, __builtin_amdgcn_ds_swizzle(__builtin_bit_cast(int, v), 0x1f | (M << 10))); }
__device__ __forceinline__ float wave_sum(float v) {
    v += swz_xor<1>(v); v += swz_xor<2>(v); v += swz_xor<4>(v); v += swz_xor<8>(v); v += swz_xor<16>(v);
    const int vb = __builtin_bit_cast(int, v);
    return __builtin_bit_cast(float, __builtin_amdgcn_readlane(vb, 0)) + __builtin_bit_cast(float, __builtin_amdgcn_readlane(vb, 32));
}
struct Args { const float* in[17]; float* out; unsigned char* ws; int ph_lo, ph_hi; };
enum { I_X = 0, I_C, I_CTX, I_CCTX, I_WMOD, I_BMOD, I_NORMG, I_FWIN, I_FWOUT, I_WIN, I_BGATE, I_LAM, I_SUBLN, I_WAO, I_WFO, I_WO, I_FINALG };

__device__ __forceinline__ void transpose_item(const float* W, int K, int N, bf16* WT, int drow0, LAS float* scr, int k0, int n0, int lane) {
    float wv[32];
#pragma unroll
    for (int i = 0; i < 32; ++i) wv[i] = W[(size_t)(k0 + 2 * i + (lane >> 5)) * N + n0 + (lane & 31)];
#pragma unroll
    for (int i = 0; i < 32; ++i) scr[(2 * i + (lane >> 5)) * 33 + (lane & 31)] = wv[i];
    asm volatile("s_waitcnt lgkmcnt(0)" ::: "memory");
    const int c = lane & 7;
#pragma unroll
    for (int j = 0; j < 4; ++j) { const int n = (lane >> 3) + 8 * j; const LAS float* s = scr + (8 * c) * 33 + n;
        v4u o; o.x = pk2(s[0 * 33], s[1 * 33]); o.y = pk2(s[2 * 33], s[3 * 33]); o.z = pk2(s[4 * 33], s[5 * 33]); o.w = pk2(s[6 * 33], s[7 * 33]);
        *(v4u*)(WT + (size_t)(drow0 + n) * K + k0 + 8 * c) = o; }
    asm volatile("s_waitcnt lgkmcnt(0)" ::: "memory");
}
__device__ __forceinline__ void convert_weights(const Args& a, int l, LAS unsigned char* lds, int gw, int NGW, int wave, int lane) {
    LAS float* scr = (LAS float*)(lds + wave * 16384);
    bf16* WB = (bf16*)(a.ws + WS_W);
    constexpr int I_FI = 16 * 176, I_FO = 44 * 32, I_IN = 16 * 176, I_SQ = 16 * 32, I_FR = 8 * 32;
    constexpr int NITEMS = 2 * I_FI + 2 * I_FO + I_IN + 2 * I_SQ + I_FR;
    for (int it = gw; it < NITEMS; it += NGW) {
        int r = it;
        if (r < 2 * I_FI) { const int i = r / I_FI; r -= i * I_FI; const int kb = r / 176, nb = r % 176, n0 = 32 * nb;
            const int drow = n0 < DFF ? (n0 / 128) * 256 + (n0 % 128) : ((n0 - DFF) / 128) * 256 + 128 + ((n0 - DFF) % 128);
            transpose_item(a.in[I_FWIN] + (size_t)(l * 2 + i) * D * INW, D, INW, WB + (i ? W_FI1 : W_FI0), drow, scr, 64 * kb, n0, lane); continue; }
        r -= 2 * I_FI;
        if (r < 2 * I_FO) { const int i = r / I_FO; r -= i * I_FO; const int kb = r / 32, nb = r % 32;
            transpose_item(a.in[I_FWOUT] + (size_t)(l * 2 + i) * DFF * D, DFF, D, WB + (i ? W_FO1 : W_FO0), 32 * nb, scr, 64 * kb, 32 * nb, lane); continue; }
        r -= 2 * I_FO;
        if (r < I_IN) { const int kb = r / 176, nb = r % 176; transpose_item(a.in[I_WIN] + (size_t)l * D * INW, D, INW, WB + W_IN, 32 * nb, scr, 64 * kb, 32 * nb, lane); continue; }
        r -= I_IN;
        if (r < I_SQ) { const int kb = r / 32, nb = r % 32; transpose_item(a.in[I_WAO] + (size_t)l * D * D, D, D, WB + W_AO, 32 * nb, scr, 64 * kb, 32 * nb, lane); continue; }
        r -= I_SQ;
        if (r < I_SQ) { const int kb = r / 32, nb = r % 32; transpose_item(a.in[I_WO] + (size_t)l * D * D, D, D, WB + W_O, 32 * nb, scr, 64 * kb, 32 * nb, lane); continue; }
        r -= I_SQ;
        { const int kb = r / 32, nb = r % 32; transpose_item(a.in[I_WFO] + (size_t)l * 512 * D, 512, D, WB + W_FR, 32 * nb, scr, 64 * kb, 32 * nb, lane); }
    }
}
__device__ __forceinline__ void norm_rows(const float* src_lat, const float* src_ctx, int nrows, const float* g, const float* mod  , bf16* U, int gw, int NGW, int lane) {
    f32x4 gv[4], shv[4], scv[4], v[4];
#pragma unroll
    for (int j = 0; j < 4; ++j) gv[j] = ((const f32x4*)g)[lane + 64 * j];
    int cur_mb = -1, row = gw;
    if (row < nrows) { const f32x4* xr = (const f32x4*)(row < LAT ? src_lat + (size_t)row * D : src_ctx + (size_t)(row - LAT) * D) + lane;
#pragma unroll
        for (int j = 0; j < 4; ++j) v[j] = xr[64 * j]; }
    while (row < nrows) {
        const int mb = row < LAT ? (row >> 13) : 2;
        if (mb != cur_mb) { cur_mb = mb; const f32x4* sh = (const f32x4*)(mod + mb * 9216) + lane; const f32x4* sc = (const f32x4*)(mod + mb * 9216 + 1024) + lane;
#pragma unroll
            for (int j = 0; j < 4; ++j) { shv[j] = sh[64 * j]; scv[j] = sc[64 * j] + 1.0f; } }
        const int nxt = row + NGW; f32x4 vn[4];
        if (nxt < nrows) { const f32x4* xr = (const f32x4*)(nxt < LAT ? src_lat + (size_t)nxt * D : src_ctx + (size_t)(nxt - LAT) * D) + lane;
#pragma unroll
            for (int j = 0; j < 4; ++j) vn[j] = xr[64 * j]; }
        float s = 0.f;
#pragma unroll
        for (int j = 0; j < 4; ++j) s += (v[j].x * v[j].x + v[j].y * v[j].y) + (v[j].z * v[j].z + v[j].w * v[j].w);
        const float rstd = 1.f / sqrtf(wave_sum(s) * (1.f / D) + EPS);
        unsigned long long* o8 = (unsigned long long*)(U + (size_t)row * D) + lane;
#pragma unroll
        for (int j = 0; j < 4; ++j) { const f32x4 y = v[j] * rstd * gv[j]; const f32x4 o = y * scv[j] + shv[j];
            o8[64 * j] = (unsigned long long)pk2(o.x, o.y) | ((unsigned long long)pk2(o.z, o.w) << 32); }
#pragma unroll
        for (int j = 0; j < 4; ++j) v[j] = vn[j];
        row = nxt;
    }
}
__device__ __forceinline__ void final_norm(const float* src, const float* g, float* out, int gw, int NGW, int lane) {
    f32x4 gv[4], v[4];
#pragma unroll
    for (int j = 0; j < 4; ++j) gv[j] = ((const f32x4*)g)[lane + 64 * j];
    int row = gw;
    if (row < LAT) { const f32x4* xr = (const f32x4*)(src + (size_t)row * D) + lane;
#pragma unroll
        for (int j = 0; j < 4; ++j) v[j] = xr[64 * j]; }
    while (row < LAT) {
        const int nxt = row + NGW; f32x4 vn[4];
        if (nxt < LAT) { const f32x4* xr = (const f32x4*)(src + (size_t)nxt * D) + lane;
#pragma unroll
            for (int j = 0; j < 4; ++j) vn[j] = xr[64 * j]; }
        float s = 0.f;
#pragma unroll
        for (int j = 0; j < 4; ++j) s += (v[j].x * v[j].x + v[j].y * v[j].y) + (v[j].z * v[j].z + v[j].w * v[j].w);
        const float rstd = 1.f / sqrtf(wave_sum(s) * (1.f / D) + EPS);
        f32x4* o = (f32x4*)(out + (size_t)row * D) + lane;
#pragma unroll
        for (int j = 0; j < 4; ++j) o[64 * j] = v[j] * rstd * gv[j];
#pragma unroll
        for (int j = 0; j < 4; ++j) v[j] = vn[j];
        row = nxt;
    }
}
__device__ __forceinline__ void combine_rows(bf16* O0, const bf16* O1, int nrows, float lam, float oml, const float* subg, int gw, int NGW, int lane) {
    float sg[16];
#pragma unroll
    for (int j = 0; j < 16; ++j) sg[j] = subg[(lane & 7) * 16 + j] * oml;
    int row = gw; v4u a[2], b[2];
    if (row < nrows) { const v4u* p0 = (const v4u*)(O0 + (size_t)row * D + lane * 16); const v4u* p1 = (const v4u*)(O1 + (size_t)row * D + lane * 16); a[0] = p0[0]; a[1] = p0[1]; b[0] = p1[0]; b[1] = p1[1]; }
    while (row < nrows) {
        const int nxt = row + NGW; v4u an[2], bn[2];
        if (nxt < nrows) { const v4u* p0 = (const v4u*)(O0 + (size_t)nxt * D + lane * 16); const v4u* p1 = (const v4u*)(O1 + (size_t)nxt * D + lane * 16); an[0] = p0[0]; an[1] = p0[1]; bn[0] = p1[0]; bn[1] = p1[1]; }
        float av[16]; float s = 0.f;
#pragma unroll
        for (int h = 0; h < 2; ++h)
#pragma unroll
            for (int j = 0; j < 4; ++j) { const float x0 = blo(a[h][j]) - lam * blo(b[h][j]), x1 = bhi(a[h][j]) - lam * bhi(b[h][j]); av[h * 8 + 2 * j] = x0; av[h * 8 + 2 * j + 1] = x1; s += x0 * x0 + x1 * x1; }
        s += swz_xor<1>(s); s += swz_xor<2>(s); s += swz_xor<4>(s);
        const float r = 1.f / sqrtf(s * (1.f / 128.f) + EPS);
        v4u* po = (v4u*)(O0 + (size_t)row * D + lane * 16);
#pragma unroll
        for (int h = 0; h < 2; ++h) { v4u o;
#pragma unroll
            for (int j = 0; j < 4; ++j) o[j] = pk2(av[h * 8 + 2 * j] * r * sg[h * 8 + 2 * j], av[h * 8 + 2 * j + 1] * r * sg[h * 8 + 2 * j + 1]);
            po[h] = o; }
        a[0] = an[0]; a[1] = an[1]; b[0] = bn[0]; b[1] = bn[1];
        row = nxt;
    }
}
__device__ __forceinline__ void mod_gemv(const Args& a, LAS unsigned char* lds, int bid, int G, int tid, int wave, int lane) {
    LAS float* sil = (LAS float*)lds;
    LAS float* red = (LAS float*)(lds + 12288);
    float* mod = (float*)(a.ws + WS_MOD);
    for (int i = tid; i < 3072; i += NTHREADS) { const int mb = i >> 10, k = i & 1023; const float c = mb < 2 ? a.in[I_C][mb * 1024 + k] : a.in[I_CCTX][k]; sil[i] = c / (1.f + expf(-c)); }
    __syncthreads();
    for (int it = bid; it < 288; it += G) {
        const int l = it / 144, cgp = it % 144, col = cgp * 64 + lane;
        const float* W = a.in[I_WMOD] + (size_t)l * 1024 * 9216 + col; const int k0 = wave * 128;
        float a0 = 0.f, a1 = 0.f, a2 = 0.f;
#pragma unroll
        for (int kb = 0; kb < 128; kb += 32) { float wv[32];
#pragma unroll
            for (int i = 0; i < 32; ++i) wv[i] = W[(size_t)(k0 + kb + i) * 9216];
#pragma unroll
            for (int i = 0; i < 32; ++i) { const int k = k0 + kb + i; a0 += sil[k] * wv[i]; a1 += sil[1024 + k] * wv[i]; a2 += sil[2048 + k] * wv[i]; } }
        red[(wave * 3 + 0) * 64 + lane] = a0; red[(wave * 3 + 1) * 64 + lane] = a1; red[(wave * 3 + 2) * 64 + lane] = a2;
        __syncthreads();
        if (tid < 192) { const int mb = tid >> 6, ln = tid & 63; float s = 0.f;
#pragma unroll
            for (int w = 0; w < 8; ++w) s += red[(w * 3 + mb) * 64 + ln];
            mod[l * 27648 + mb * 9216 + cgp * 64 + ln] = s + a.in[I_BMOD][l * 9216 + cgp * 64 + ln]; }
        __syncthreads();
    }
}
__device__ __forceinline__ void make_tables(const Args& a, int gtid, int NT_) {
    cs2* rope = (cs2*)(a.ws + WS_ROPE); cs2* tw = (cs2*)(a.ws + WS_TW8192); cs2* tw256 = (cs2*)(a.ws + WS_TW256);
    bf16* Wb = (bf16*)(a.ws + WS_WB); bf16* Wc = (bf16*)(a.ws + WS_WC); bf16* WBD = (bf16*)(a.ws + WS_WBD);
    for (int i = gtid; i < 2048; i += NT_) { const int pos = i >> 4, f = i & 15; const float inv = 1.0f / powf(10000.0f, (float)(2 * f) / 32.0f); const float ang = (float)pos * inv; cs2 v; v.x = cosf(ang); v.y = sinf(ang); rope[i] = v; }
    for (int i = gtid; i < 8192; i += NT_) { cs2 v; v.x = cospif((float)i / 4096.0f); v.y = sinpif((float)i / 4096.0f); tw[i] = v; }
    for (int i = gtid; i < 256; i += NT_) { cs2 v; v.x = cospif((float)i / 128.0f); v.y = sinpif((float)i / 128.0f); tw256[i] = v; }
    for (int i = gtid; i < 65536; i += NT_) { const int m = i >> 8, k = i & 255, ap = m >> 1, ro = m & 1, aa = k >> 1, ri = k & 1; const int idx = (ap * aa) & 127;
        const float c = cospif((float)idx / 64.0f), s = sinpif((float)idx / 64.0f); const float v = (ro == ri) ? c : (ro == 0 ? s : -s); Wb[i] = (bf16)f2bf(v); }
    for (int i = gtid; i < 8192; i += NT_) { const int rp = i >> 7, k = i & 127, r = k >> 1, ro = k & 1; const int idx = (rp * r) & 63;
        const float v = ro == 0 ? cospif((float)idx / 32.0f) : sinpif((float)idx / 32.0f); Wc[i] = (bf16)f2bf(v); }
    for (int i = gtid; i < 1024 * 512; i += NT_) { const int n = i >> 9, k = i & 511; const int cc = n >> 1, reim = n & 1, g = cc >> 7, cp = cc & 127, g2 = k >> 7, c = k & 127;
        float v = 0.f; if (g == g2) { const int idx = (c * cp) & 127; v = reim == 0 ? cospif((float)idx / 64.0f) : -sinpif((float)idx / 64.0f); } WBD[i] = (bf16)f2bf(v); }
    { bf16* Wx = (bf16*)(a.ws + WS_FMC);
      for (int i = gtid; i < 512 * 1024; i += NT_) { const int row = i >> 10, k = i & 1023, b = row >> 8, sp = row & 255, b2 = k >> 9, s_ = (k >> 1) & 255, ri = k & 1;
          float v = 0.f; if (b == b2) { const int idx = (s_ * sp) & 255; v = ri == 0 ? cospif((float)idx / 128.0f) : sinpif((float)idx / 128.0f); } Wx[i] = (bf16)f2bf(v); } }
    if (gtid < 2) {
        const int l = gtid; const float* lp = a.in[I_LAM] + l * 256; float s1 = 0.f, s2 = 0.f;
        for (int d = 0; d < 64; ++d) { s1 += lp[d] * lp[64 + d]; s2 += lp[128 + d] * lp[192 + d]; }
        const float lam_init = 0.8f - 0.6f * expf(-0.3f * (float)l);
        ((float*)(a.ws + WS_LAM))[l] = expf(s1) - expf(s2) + lam_init;
    }
}
__device__ __forceinline__ void seqdft_lat(const Args& a, LAS unsigned char* lds, int bid, int G, int tid, int wave, int lane) {
    const bf16* Z = (const bf16*)(a.ws + WS_Z); bf16* FMc = (bf16*)(a.ws + WS_FMC);
    const bf16* Wb = (const bf16*)(a.ws + WS_WB); const bf16* Wc = (const bf16*)(a.ws + WS_WC); const cs2* tw = (const cs2*)(a.ws + WS_TW8192);
    const int r32 = lane & 31, hi = lane >> 5, w = wave;
    for (int job = bid; job < 512; job += G) {
        const int b = job >> 8, chunk = job & 255;
        const v4u* src = (const v4u*)(Z + (size_t)(b * 256 + chunk) * 8192 * 4);
#pragma unroll
        for (int i = 0; i < 8; ++i) ((LAS v4u*)lds)[i * 512 + tid] = src[i * 512 + tid];
        __syncthreads();
        f32x16 acc[4];
#pragma unroll
        for (int nt = 0; nt < 4; ++nt) acc[nt] = f32x16{};
        const bf16* wrow = Wb + (32 * w + r32) * 256 + 8 * hi;
#pragma unroll 4
        for (int kt = 0; kt < 16; ++kt) {
            const bf16x8 af = *(const bf16x8*)(wrow + 16 * kt);
#pragma unroll
            for (int nt = 0; nt < 4; ++nt) {
                const LAS unsigned char* p = lds + 512 * (8 * kt + 4 * hi) + 4 * (32 * nt + r32);
                v4u wv; wv.x = *(const LAS unsigned*)(p); wv.y = *(const LAS unsigned*)(p + 512); wv.z = *(const LAS unsigned*)(p + 1024); wv.w = *(const LAS unsigned*)(p + 1536);
                acc[nt] = __builtin_amdgcn_mfma_f32_32x32x16_bf16(af, __builtin_bit_cast(bf16x8, wv), acc[nt], 0, 0, 0);
            }
        }
#pragma unroll
        for (int nt = 0; nt < 4; ++nt) { const int n = 32 * nt + r32, r = n >> 1, cj = n & 1;
#pragma unroll
            for (int p = 0; p < 8; ++p) { const int ap = 16 * w + (p & 1) + 4 * (p >> 1) + 2 * hi; const float tr = acc[nt][2 * p], ti = acc[nt][2 * p + 1]; const cs2 cs = tw[r * ap];
                const float re = tr * cs.x + ti * cs.y, im = ti * cs.x - tr * cs.y;
                *(LAS unsigned*)(lds + 65536 + (2 * ap + cj) * 272 + 4 * r) = pk2(re, im); } }
        __syncthreads();
        f32x16 c2[2]; c2[0] = f32x16{}; c2[1] = f32x16{};
#pragma unroll
        for (int kt = 0; kt < 8; ++kt) {
            const bf16x8 bfr = *(const LAS bf16x8*)(lds + 65536 + (32 * w + r32) * 272 + (16 * kt + 8 * hi) * 2);
#pragma unroll
            for (int mt = 0; mt < 2; ++mt) { const bf16x8 af = *(const bf16x8*)(Wc + (32 * mt + r32) * 128 + 16 * kt + 8 * hi); c2[mt] = __builtin_amdgcn_mfma_f32_32x32x16_bf16(af, bfr, c2[mt], 0, 0, 0); }
        }
        { int ln2 = lane; asm volatile("" : "+v"(ln2));
          const int r32o = ln2 & 31, hio = ln2 >> 5; unsigned char* wsl = a.ws; asm volatile("" : "+s"(wsl)); bf16* FMo = (bf16*)(wsl + WS_FM);
          const int n2 = 32 * w + r32o, ap2 = n2 >> 1, cj2 = n2 & 1;
#pragma unroll
          for (int mt = 0; mt < 2; ++mt)
#pragma unroll
            for (int r16 = 0; r16 < 16; ++r16) { const int rp = 32 * mt + (r16 & 3) + 8 * (r16 >> 2) + 4 * hio; const int tok = ap2 + 128 * rp;
                FMo[(size_t)(b * 8192 + tok) * 512 + chunk * 2 + cj2] = (bf16)f2bf(c2[mt][r16] * (1.0f / 1024.0f)); } }
        __syncthreads();
    }
}
__device__ __forceinline__ void seqdft_ctx(const Args& a, int gtid, int NT_) {
    const bf16* Zc = (const bf16*)(a.ws + WS_Z) + (size_t)LAT * 1024; bf16* FM = (bf16*)(a.ws + WS_FM); const cs2* tw256 = (const cs2*)(a.ws + WS_TW256);
    for (int o = gtid; o < 2 * 256 * 512; o += NT_) {
        const int sp = o & 255, cc = (o >> 8) & 511, b = o >> 17, chunk = cc >> 1, cj = cc & 1;
        const unsigned* z = (const unsigned*)(Zc + (size_t)((b * 256 + chunk) * 256) * 4 + cj * 2);
        float acc = 0.f;
#pragma unroll 16
        for (int s = 0; s < 256; ++s) { const unsigned wv = z[s * 2]; const cs2 cs = tw256[(s * sp) & 255]; acc += blo(wv) * cs.x + bhi(wv) * cs.y; }
        FM[(size_t)(LAT + b * 256 + sp) * 512 + cc] = (bf16)f2bf(acc * 0.005524271728f);
    }
}

__device__ __forceinline__ void fm_transpose(const Args& a, LAS unsigned char* lds, int bid, int G, int tid) {
    const unsigned* FMc = (const unsigned*)(a.ws + WS_FMC); unsigned* FM = (unsigned*)(a.ws + WS_FM);
    LAS unsigned* T = (LAS unsigned*)lds;
    for (int item = bid; item < 256; item += G) {
        const int b = item >> 7, tt = item & 127;
#pragma unroll 8
        for (int it = 0; it < 32; ++it) { const int i = it * 512 + tid, chunk = i >> 6, tokl = i & 63; T[chunk * 65 + tokl] = FMc[(size_t)(b * 256 + chunk) * 8192 + tt * 64 + tokl]; }
        __syncthreads();
#pragma unroll 8
        for (int it = 0; it < 32; ++it) { const int i = it * 512 + tid, tokl = i >> 8, chunk = i & 255; FM[(size_t)(b * 8192 + tt * 64 + tokl) * 256 + chunk] = T[chunk * 65 + tokl]; }
        __syncthreads();
    }
}

#define XB_TMO      128
#define XB_XCNT(j)  (256  + 64 * (j))
#define XB_XSUB(j)  (1280 + 64 * (j))
#define XB_XGEN(j)  (2304 + 64 * (j))
#define XB_TOP      3328
#define XB_TOPGEN   3392
#define XCD_BAR_WORDS 3456
#define XB_SPIN_CAP (1u << 18)

__device__ __forceinline__ unsigned xb_ld(unsigned* p)              { return __hip_atomic_load(p, __ATOMIC_RELAXED, __HIP_MEMORY_SCOPE_AGENT); }
__device__ __forceinline__ unsigned xb_add(unsigned* p, unsigned v) { return __hip_atomic_fetch_add(p, v, __ATOMIC_RELAXED, __HIP_MEMORY_SCOPE_AGENT); }
__device__ __forceinline__ unsigned xb_xcc_id() { return (unsigned)__builtin_amdgcn_s_getreg((3 << 11) | 20) & 0xFu; }
#define XB_SPIN(cond, bar) do { unsigned _sp = 0; while (cond) { __builtin_amdgcn_s_sleep(1); \
    if ((++_sp & 255u) == 0u) { if (xb_ld(&(bar)[XB_TMO])) break; if (_sp > XB_SPIN_CAP) { atomicAdd(&(bar)[XB_TMO], 1u); break; } } } } while (0)

struct XcdBarrier {
    unsigned* bar; unsigned x;
    volatile LAS unsigned* st;
};

__device__ __forceinline__ XcdBarrier xcd_barrier_post(unsigned* bar, volatile LAS unsigned* st) {
    XcdBarrier b; b.bar = bar; b.x = xb_xcc_id(); b.st = st;
    if (threadIdx.x == 0) (void)xb_add(&bar[XB_XCNT(b.x)], 1u);
    return b;
}
__device__ __forceinline__ void xcd_barrier_complete(unsigned* bar, unsigned x, unsigned& nloc, unsigned& nx) {
    const unsigned G = gridDim.x * gridDim.y * gridDim.z;
    unsigned sum, cnt, mine, sp = 0u;
    for (;;) {
        sum = 0u; cnt = 0u; mine = 0u;
#pragma unroll
        for (unsigned j = 0; j < 16; ++j) { const unsigned c = xb_ld(&bar[XB_XCNT(j)]); sum += c; cnt += (c > 0u) ? 1u : 0u; mine = (j == x) ? c : mine; }
        if (sum == G) break;
        __builtin_amdgcn_s_sleep(1);
        if ((++sp & 255u) == 0u) { if (xb_ld(&bar[XB_TMO])) break; if (sp > XB_SPIN_CAP) { atomicAdd(&bar[XB_TMO], 1u); break; } }
    }
    nloc = mine > 0u ? mine : 1u; nx = cnt > 0u ? cnt : 1u;
}

__device__ __forceinline__ void xcd_barrier(const XcdBarrier& b) {
    asm volatile("s_waitcnt vmcnt(0)" ::: "memory");
    __syncthreads();
    if (threadIdx.x == 0) {
        unsigned* bar = b.bar;
        __builtin_amdgcn_s_waitcnt(0);
        unsigned nloc = b.st[0], nx = b.st[1];
        if (nloc == 0u) { xcd_barrier_complete(bar, b.x, nloc, nx); b.st[0] = nloc; b.st[1] = nx; }
        const unsigned old = xb_add(&bar[XB_XSUB(b.x)], 1u);
        const unsigned gen = old / nloc;
        if (old + 1u == (gen + 1u) * nloc) {
            __builtin_amdgcn_fence(__ATOMIC_RELEASE, "agent");
            asm volatile("s_waitcnt vmcnt(0)" ::: "memory");
            const unsigned og = xb_add(&bar[XB_TOP], 1u);
            const unsigned tg = og / nx;
            if (og + 1u == (tg + 1u) * nx) xb_add(&bar[XB_TOPGEN], 1u);
            else XB_SPIN(xb_ld(&bar[XB_TOPGEN]) == tg, bar);
            __builtin_amdgcn_fence(__ATOMIC_ACQUIRE, "agent");
            xb_add(&bar[XB_XGEN(b.x)], 1u);
            asm volatile("s_waitcnt vmcnt(0)" ::: "memory");
        } else {
            XB_SPIN(xb_ld(&bar[XB_XGEN(b.x)]) == gen, bar);
            __builtin_amdgcn_fence(__ATOMIC_ACQUIRE, "agent");
            asm volatile("s_waitcnt vmcnt(0)" ::: "memory");
        }
    }
    __syncthreads();
}

constexpr size_t WS_BAR = 448 * 1024;
constexpr int LDS_MISC = LDS_BYTES - 64;

struct CtxResid { const float* base; float* X; const float* gate; float coef;
    __device__ __forceinline__ void operator()(int row, int col, float v) const { const size_t o = (size_t)row * D + col; X[o] = base[o] + coef * gate[col] * v; } };
struct CtxGateMul { const bf16* G; bf16* MG; int goff; bool add;
    __device__ __forceinline__ void operator()(int row, int col, float v) const { const size_t o = (size_t)row * D + col; float r = pg8::bf2f(G[(size_t)row * 2048 + goff + col]) * v; if (add) r += pg8::bf2f(MG[o]); MG[o] = (bf16)f2bf(r); } };
struct CtxGates { bf16* G; const float* bias;
    __device__ __forceinline__ void operator()(int row, int col, float v) const { G[(size_t)row * 2048 + col] = (bf16)f2bf(1.0f / (1.0f + __expf(-(v + bias[col])))); } };
struct CtxChanDFT { bf16* Zc;
    __device__ __forceinline__ void operator()(int row, int col, float v) const { Zc[(size_t)(col >> 1) * 1024 + row * 2 + (col & 1)] = (bf16)f2bf(v); } };
struct CtxDftOut { bf16* FMc;
    __device__ __forceinline__ void operator()(int row, int col, float v) const { FMc[(size_t)row * 512 + col] = (bf16)f2bf(v * 0.005524271728f); } };
template <class F> __device__ __forceinline__ void ctx_gemm(const bf16* A, const bf16* Bt, int N, int K, LAS unsigned char* lds, int bid, int G, int wave, int lane, const F& epi) {
    const int r32 = lane & 31, hi = lane >> 5, ks = wave & 3, kq = K >> 2, ntn = N >> 5, npairs = 8 * ntn;
    LAS float* red = (LAS float*)lds;
    for (int tp = bid; tp < npairs; tp += G) {
        const int tile = 2 * tp + (wave >> 2), tm = tile / ntn, tn = tile % ntn;
        const bf16* ap = A + (size_t)(tm * 32 + r32) * K + ks * kq + 8 * hi; const bf16* bp = Bt + (size_t)(tn * 32 + r32) * K + ks * kq + 8 * hi;
        f32x16 acc = f32x16{};
#pragma unroll 8
        for (int k = 0; k < kq; k += 16) { const bf16x8 a = *(const bf16x8*)(ap + k), b = *(const bf16x8*)(bp + k); acc = __builtin_amdgcn_mfma_f32_32x32x16_bf16(a, b, acc, 0, 0, 0); }
#pragma unroll
        for (int r = 0; r < 16; ++r) red[(wave * 16 + r) * 64 + lane] = acc[r];
        __syncthreads();
        if (ks == 0) {
#pragma unroll
            for (int r = 0; r < 16; ++r) { const float v = (red[(wave * 16 + r) * 64 + lane] + red[((wave + 1) * 16 + r) * 64 + lane]) + (red[((wave + 2) * 16 + r) * 64 + lane] + red[((wave + 3) * 16 + r) * 64 + lane]);
                epi(tm * 32 + (r & 3) + 8 * (r >> 2) + 4 * hi, tn * 32 + r32, v); }
        }
        __syncthreads();
    }
}

#ifndef CUT
#define CUT -1
#endif
#ifndef DUMPSEL
#define DUMPSEL 0
#endif
__device__ __forceinline__ void dump_buf(const Args& args, int gtid, int NTH) {
    unsigned char* ws = args.ws; const bf16* U = (const bf16*)(ws + WS_U); const float* X = (const float*)(ws + WS_X);
    const bf16 *Qb = (const bf16*)(ws + WS_Q), *Kb = (const bf16*)(ws + WS_K), *Vb = (const bf16*)(ws + WS_V), *Fb = (const bf16*)(ws + WS_F), *O0 = (const bf16*)(ws + WS_O0), *O1 = (const bf16*)(ws + WS_O1);
    const bf16 *Hb = (const bf16*)(ws + WS_H), *Zb = (const bf16*)(ws + WS_Z), *Gb = (const bf16*)(ws + WS_G), *FMb = (const bf16*)(ws + WS_FM), *MGb = (const bf16*)(ws + WS_MG);
    for (size_t i = gtid; i < (size_t)LAT * D; i += NTH) { const size_t row = i >> 10; const int col = (int)(i & 1023); float v = 0.f;
        switch (DUMPSEL) {
            case 0: v = pg8::bf2f(U[i]); break;
            case 1: v = pg8::bf2f(Hb[row * DFF + col]) + pg8::bf2f(Hb[row * DFF + 1024 + col]) + pg8::bf2f(Hb[row * DFF + 1792 + col]); break;
            case 2: v = X[i]; break;
            case 3: v = pg8::bf2f(Qb[i]); break;
            case 4: v = pg8::bf2f(Kb[i]) + pg8::bf2f(Vb[i]); break;
            case 5: v = pg8::bf2f(Fb[row * 512 + (col & 511)]); break;
            case 6: v = pg8::bf2f(O0[i]) + pg8::bf2f(O1[i]); break;
            case 7: v = pg8::bf2f(O0[i]); break;
            case 8: v = pg8::bf2f(Zb[i]); break;
            case 9: v = pg8::bf2f(Gb[row * 2048 + col]) + pg8::bf2f(Gb[row * 2048 + 1024 + col]); break;
            case 10: v = pg8::bf2f(FMb[row * 512 + (col & 511)]); break;
            case 11: v = pg8::bf2f(MGb[i]); break;
            case 13: { const unsigned* gp = (const unsigned*)Gb; const unsigned w0 = __hip_atomic_load(gp + (row * 2048 + col) / 2, __ATOMIC_RELAXED, __HIP_MEMORY_SCOPE_AGENT), w1 = __hip_atomic_load(gp + (row * 2048 + 1024 + col) / 2, __ATOMIC_RELAXED, __HIP_MEMORY_SCOPE_AGENT);
                       v = ((col & 1) ? bhi(w0) : blo(w0)) + ((col & 1) ? bhi(w1) : blo(w1)); } break;
            case 14: v = (i < (size_t)2048 * 1024) ? pg8::bf2f(((const bf16*)(ws + WS_W))[W_IN + (size_t)3584 * 1024 + i]) : pg8::bf2f(((const bf16*)(ws + WS_W))[W_IN + (i - (size_t)2048 * 1024) % ((size_t)3584 * 1024)]); break;
            case 12: v = ((const float*)(ws + WS_MOD))[i % 55296]; break;
        }
        args.out[i] = v; }
}
constexpr int N_PHASES = 30;
typedef __attribute__((address_space(4))) const Args* kargp_t;
__device__ __forceinline__ kargp_t kargs() { kargp_t p = (kargp_t)__builtin_amdgcn_kernarg_segment_ptr(); asm volatile("" : "+s"(p)); return p; }
__device__ __forceinline__ Args load_args() { kargp_t p = kargs(); Args a;
#pragma unroll
    for (int i = 0; i < 17; ++i) a.in[i] = p->in[i];
    a.out = p->out; a.ws = p->ws; a.ph_lo = p->ph_lo; a.ph_hi = p->ph_hi; return a; }
__global__ void __launch_bounds__(NTHREADS, 2) fwd_mega(Args kernel_args) {
    extern __shared__ __attribute__((aligned(16))) unsigned char lds_raw[];
    LAS unsigned char* lds = (LAS unsigned char*)lds_raw;
    cg::grid_group grid = cg::this_grid();
    const int lo = kargs()->ph_lo, hi = kargs()->ph_hi;
    if (threadIdx.x < 16) ((LAS unsigned*)(lds + LDS_MISC))[threadIdx.x] = 0u;
    if (blockIdx.x == 0) { for (int i = threadIdx.x; i < XCD_BAR_WORDS; i += NTHREADS) ((unsigned*)(kargs()->ws + WS_BAR))[i] = 0u; for (int i = threadIdx.x; i < 8192; i += NTHREADS) ((unsigned*)(kargs()->ws + WS_CNT))[i] = 0u; __builtin_amdgcn_fence(__ATOMIC_RELEASE, "agent"); asm volatile("s_waitcnt vmcnt(0)" ::: "memory"); }
    __syncthreads();
    grid.sync();
    if (threadIdx.x == 0) (void)xb_add((unsigned*)(kargs()->ws + WS_BAR) + XB_XCNT(xb_xcc_id()), 1u);
#define LY_LOCALS const float* modl = mod + l * 27648; const float* ng = args.in[I_NORMG] + l * 3 * 1024; const float* src_lat = (l == 0) ? args.in[I_X] : X; const float* src_ctx = (l == 0) ? args.in[I_CTX] : X + (size_t)LAT * D; (void)modl; (void)ng; (void)src_lat; (void)src_ctx;
#define PH_LOCALS const Args args = load_args(); int tid = threadIdx.x; asm volatile("" : "+v"(tid)); const int lane = tid & 63, wave = __builtin_amdgcn_readfirstlane(tid >> 6); const int G = gridDim.x, bid = blockIdx.x; const int vcu = (G % 8 == 0) ? (bid % 8) * (G / 8) + bid / 8 : bid; const int gw = vcu * NWAVES + wave, NGW = G * NWAVES, gtid = bid * NTHREADS + tid, NTH = G * NTHREADS; (void)lane; (void)gw; (void)NGW; (void)gtid; (void)NTH; unsigned char* ws = args.ws; float* mod = (float*)(ws + WS_MOD); bf16* WB = (bf16*)(ws + WS_W); float* X = (float*)(ws + WS_X); bf16* U = (bf16*)(ws + WS_U); bf16 *Qb = (bf16*)(ws + WS_Q), *Kb = (bf16*)(ws + WS_K), *Vb = (bf16*)(ws + WS_V), *Fb = (bf16*)(ws + WS_F), *O0 = (bf16*)(ws + WS_O0), *O1 = (bf16*)(ws + WS_O1); bf16 *Hb = (bf16*)(ws + WS_H), *Zb = (bf16*)(ws + WS_Z), *Gb = (bf16*)(ws + WS_G), *FMb = (bf16*)(ws + WS_FM), *MGb = (bf16*)(ws + WS_MG); (void)mod; (void)WB; (void)X; (void)U; (void)Qb; (void)Kb; (void)Vb; (void)Fb; (void)O0; (void)O1; (void)Hb; (void)Zb; (void)Gb; (void)FMb; (void)MGb;
#ifndef REPMASK
#define REPMASK 0
#endif
#define PH_BEGIN(k) if (lo <= (k) && (k) < hi) { for (int rep_ = 0; rep_ < (((REPMASK >> ((k) == 0 ? 0 : ((k) == 29 ? 15 : 1 + ((k) - 1) % 14))) & 1) ? 2 : 1); ++rep_) { if (rep_) __syncthreads(); PH_LOCALS
#define PH_END(k) } if ((k) + 1 < hi) { XcdBarrier b_; b_.bar = (unsigned*)(kargs()->ws + WS_BAR); b_.x = xb_xcc_id(); b_.st = (volatile LAS unsigned*)(lds + LDS_MISC); xcd_barrier(b_); } else { __syncthreads(); } if (CUT == (k)) { const Args a2 = load_args(); dump_buf(a2, blockIdx.x * NTHREADS + threadIdx.x, gridDim.x * NTHREADS); return; } }
    using pg8::Gemm; using pg8::StaticOrder;
#define RUN_GEMM(EPI, Aptr, Bptr, Mrows, Ncols, Kdim, cidx, ...) do { Gemm g_{(const pg8::bf16_t*)(Aptr), (const pg8::bf16_t*)(Bptr), (Mrows), (Ncols), (Kdim)}; StaticOrder S_; S_.init((Mrows), (Ncols), G, (cidx)); \
        EPI E_{__VA_ARGS__}; pg8::gemm_phase<EPI, StaticOrder, true, true>(lds, g_, S_, E_); } while (0)

#define RUN_GEMM_AD(EPI, Aptr, Bptr, Mrows, Ncols, Kdim, cidx, ...) do { Gemm g_{(const pg8::bf16_t*)(Aptr), (const pg8::bf16_t*)(Bptr), (Mrows), (Ncols), (Kdim)}; StaticOrder S_; S_.init((Mrows), (Ncols), G, (cidx)); \
        EPI E_{__VA_ARGS__}; pg8::gemm_phase<EPI, StaticOrder, false, true>(lds, g_, S_, E_); } while (0)
    PH_BEGIN(0)
        mod_gemv(args, lds, bid, G, tid, wave, lane);
        make_tables(args, gtid, NTH);
        __syncthreads();
        convert_weights(args, 0, lds, gw, NGW, wave, lane);
    PH_END(0)

    for (int l = 0; l < 2; ++l) {
        const int pb = 1 + 14 * l;
        const bool last = (l == 1);
        const int Mtail = last ? LAT : MT;
        PH_BEGIN(pb + 0) LY_LOCALS
            norm_rows(src_lat, src_ctx, MT, ng, modl, U, gw, NGW, lane);
            if (l == 1) convert_weights(args, 1, lds, gw, NGW, wave, lane);
        PH_END(pb + 0)
        PH_BEGIN(pb + 1) LY_LOCALS
            RUN_GEMM(pg8::EpiSwiGLU, U, WB + W_FI0, MT, INW, D, bid, (pg8::bf16_t*)Hb);
        PH_END(pb + 1)
        PH_BEGIN(pb + 2) LY_LOCALS
            RUN_GEMM(pg8::EpiResid, Hb, WB + W_FO0, LAT, D, DFF, bid, src_lat, src_ctx, X, modl + 2 * 1024, 0.5f);
            __syncthreads();
            { const CtxResid ce{src_ctx, X + (size_t)LAT * D, modl + 2 * 9216 + 2 * 1024, 0.5f}; ctx_gemm(Hb + (size_t)LAT * DFF, WB + W_FO0, D, DFF, lds, bid, G, wave, lane, ce); }
        PH_END(pb + 2)
        PH_BEGIN(pb + 3) LY_LOCALS
            norm_rows(X, X + (size_t)LAT * D, MT, ng + 1024, modl + 3 * 1024, U, gw, NGW, lane);
        PH_END(pb + 3)
        PH_BEGIN(pb + 4) LY_LOCALS
            RUN_GEMM(pg8::EpiQKVF, U, WB + W_IN, MT, 3584, D, bid, (pg8::bf16_t*)Qb, (pg8::bf16_t*)Kb, (pg8::bf16_t*)Vb, (pg8::bf16_t*)Fb, (const pg8::cs2_t*)(ws + WS_ROPE));
        PH_END(pb + 4)
        PH_BEGIN(pb + 5) LY_LOCALS
            for (int id = vcu; id < 1024; id += G) {
                const int qb = id & 31, j = (id >> 5) & 15, b = id >> 9;
                const size_t qrow = (size_t)(b * SEQ + qb * 256) * D, kvrow = (size_t)b * 8448 * D; const int vcol = (j >> 1) * 128;
                attn_body::attn_unit<8>((const attn_body::bf16*)(Qb + qrow + j * 64), (const attn_body::bf16*)(Kb + kvrow + j * 64), (const attn_body::bf16*)(Vb + kvrow + vcol),
                                        (attn_body::bf16*)(((j & 1) ? O1 : O0) + qrow + vcol), 132, (char*)lds_raw);
            }
            if (!last) for (int id = vcu; id < 32; id += G) {
                const int j = id & 15, b = id >> 4;
                const size_t qrow = (size_t)(LAT + b * 256) * D, kvrow = (size_t)b * 8448 * D; const int vcol = (j >> 1) * 128;
                attn_body::attn_unit<8>((const attn_body::bf16*)(Qb + qrow + j * 64), (const attn_body::bf16*)(Kb + kvrow + j * 64), (const attn_body::bf16*)(Vb + kvrow + vcol),
                                        (attn_body::bf16*)(((j & 1) ? O1 : O0) + qrow + vcol), 4, (char*)lds_raw);
            }
        PH_END(pb + 5)
        PH_BEGIN(pb + 6) LY_LOCALS
            RUN_GEMM(pg8::EpiGates, U, WB + W_IN + (size_t)3584 * D, LAT, 2048, D, bid, (pg8::bf16_t*)Gb, args.in[I_BGATE] + l * 2048);
            __syncthreads();
            if (!last) { const CtxGates ce{Gb + (size_t)LAT * 2048, args.in[I_BGATE] + l * 2048}; ctx_gemm(U + (size_t)LAT * D, WB + W_IN + (size_t)3584 * D, 2048, D, lds, bid, G, wave, lane, ce); }
            __syncthreads();
#ifndef ONLYGATES
            { const float lam = ((const float*)(ws + WS_LAM))[l]; const float lam_init = 0.8f - 0.6f * expf(-0.3f * (float)l);
              combine_rows(O0, O1, Mtail, lam, 1.0f - lam_init, args.in[I_SUBLN] + l * 128, gw, NGW, lane); }
            __syncthreads();
            RUN_GEMM(pg8::EpiChanDFT, Fb, ws + WS_WBD, LAT, 1024, 512, bid, (pg8::bf16_t*)Zb);
            __syncthreads();
            if (!last) { const CtxChanDFT ce{Zb + (size_t)LAT * 1024}; ctx_gemm(Fb + (size_t)LAT * 512, (const bf16*)(ws + WS_WBD), 1024, 512, lds, bid, G, wave, lane, ce); }
            __syncthreads();
#endif
        PH_END(pb + 6)
        PH_BEGIN(pb + 7) LY_LOCALS
            seqdft_lat(args, lds, bid, G, tid, wave, lane);
            __syncthreads();
            if (!last) { const CtxDftOut ce{FMb + (size_t)LAT * 512}; ctx_gemm((const bf16*)(ws + WS_FMC), Zb + (size_t)LAT * 1024, 512, 1024, lds, bid, G, wave, lane, ce); }
        PH_END(pb + 7)
        PH_BEGIN(pb + 8) LY_LOCALS
            RUN_GEMM(pg8::EpiGateMul<false>, O0, WB + W_AO, LAT, D, D, bid, (const pg8::bf16_t*)Gb, (pg8::bf16_t*)MGb, 0);
            __syncthreads();
            RUN_GEMM(pg8::EpiGateMul<true>, FMb, WB + W_FR, LAT, D, 512, bid, (const pg8::bf16_t*)Gb, (pg8::bf16_t*)MGb, 1024);
            __syncthreads();
            if (!last) { const CtxGateMul ce{Gb + (size_t)LAT * 2048, MGb + (size_t)LAT * D, 0, false}; ctx_gemm(O0 + (size_t)LAT * D, WB + W_AO, D, D, lds, bid, G, wave, lane, ce); }
            __syncthreads();
            if (!last) { const CtxGateMul ce{Gb + (size_t)LAT * 2048, MGb + (size_t)LAT * D, 1024, true}; ctx_gemm(FMb + (size_t)LAT * 512, WB + W_FR, D, 512, lds, bid, G, wave, lane, ce); }
        PH_END(pb + 8)
        PH_BEGIN(pb + 10) LY_LOCALS
            if (last && G == 256) { const pg8::RmsExchange ex{(unsigned*)(ws + WS_SLOTS), (unsigned*)(ws + WS_CNT)};
                RUN_GEMM_AD(pg8::EpiResidNorm<false>, MGb, WB + W_O, LAT, D, D, bid, X, X, modl + 5 * 1024, 1.0f, ng + 2048, modl + 6 * 1024, (pg8::bf16_t*)U, (float*)nullptr, ex); }
            else
            RUN_GEMM(pg8::EpiResid, MGb, WB + W_O, LAT, D, D, bid, X, X + (size_t)LAT * D, X, modl + 5 * 1024, 1.0f);
            __syncthreads();
            if (!last) { const CtxResid ce{X + (size_t)LAT * D, X + (size_t)LAT * D, modl + 2 * 9216 + 5 * 1024, 1.0f}; ctx_gemm(MGb + (size_t)LAT * D, WB + W_O, D, D, lds, bid, G, wave, lane, ce); }
        PH_END(pb + 10)
        if (!(last && gridDim.x == 256)) {
        PH_BEGIN(pb + 11) LY_LOCALS
            norm_rows(X, X + (size_t)LAT * D, Mtail, ng + 2048, modl + 6 * 1024, U, gw, NGW, lane);
        PH_END(pb + 11)
        }
        PH_BEGIN(pb + 12) LY_LOCALS
            RUN_GEMM(pg8::EpiSwiGLU, U, WB + W_FI1, Mtail, INW, D, bid, (pg8::bf16_t*)Hb);
        PH_END(pb + 12)
        PH_BEGIN(pb + 13) LY_LOCALS
            if (last && G == 256) { const pg8::RmsExchange ex{(unsigned*)(ws + WS_SLOTS) + (size_t)LAT * 4, (unsigned*)(ws + WS_CNT) + 4096};
                RUN_GEMM_AD(pg8::EpiResidNorm<true>, Hb, WB + W_FO1, LAT, D, DFF, bid, X, X, modl + 8 * 1024, 0.5f, args.in[I_FINALG], modl, (pg8::bf16_t*)U, args.out, ex); }
            else
            RUN_GEMM(pg8::EpiResid, Hb, WB + W_FO1, LAT, D, DFF, bid, X, X + (size_t)LAT * D, X, modl + 8 * 1024, 0.5f);
            __syncthreads();
            if (!last) { const CtxResid ce{X + (size_t)LAT * D, X + (size_t)LAT * D, modl + 2 * 9216 + 8 * 1024, 0.5f}; ctx_gemm(Hb + (size_t)LAT * DFF, WB + W_FO1, D, DFF, lds, bid, G, wave, lane, ce); }
        PH_END(pb + 13)
    }
    if (gridDim.x != 256) {
    PH_BEGIN(29)
        final_norm(X, args.in[I_FINALG], args.out, gw, NGW, lane);
    PH_END(29)
    }
#undef PH_BEGIN
#undef PH_END
#undef RUN_GEMM
}

#ifndef MK_MULTI
#define MK_MULTI 0
#endif
extern "C" void kernel_launch(void* const* d_in, const int* in_sizes, int n_in, void* d_out, int out_size, void* d_ws, size_t ws_size, hipStream_t stream) {
    static int grid = 0;
    if (grid == 0) {
        if (n_in != 17 || ws_size < WS_END) { fprintf(stderr, "kernel_launch: need 17 inputs and %zu bytes of workspace (got %d, %zu)\n", (size_t)WS_END, n_in, ws_size); grid = -1; return; }
        int dev = 0, cus = 0, per_cu = 0;
        hipGetDevice(&dev); hipDeviceGetAttribute(&cus, hipDeviceAttributeMultiprocessorCount, dev);
        if (hipFuncSetAttribute((const void*)fwd_mega, hipFuncAttributeMaxDynamicSharedMemorySize, LDS_BYTES) != hipSuccess) { fprintf(stderr, "kernel_launch: hipFuncSetAttribute failed\n"); grid = -1; return; }
        hipOccupancyMaxActiveBlocksPerMultiprocessor(&per_cu, (const void*)fwd_mega, NTHREADS, LDS_BYTES);
        if (per_cu < 1) { fprintf(stderr, "kernel_launch: occupancy query says %d blocks per CU\n", per_cu); per_cu = 1; }
        (void)hipGetLastError();
        grid = cus;
    }
    if (grid < 0) return;
    Args a{};
    for (int i = 0; i < 17; ++i) a.in[i] = (const float*)d_in[i];
    a.out = (float*)d_out; a.ws = (unsigned char*)d_ws;
    a.ph_lo = 0; a.ph_hi = (grid == 256) ? N_PHASES - 1 : N_PHASES;
    void* kargs[] = {&a};
    hipError_t e = hipLaunchCooperativeKernel((const void*)fwd_mega, dim3(grid), dim3(NTHREADS), kargs, LDS_BYTES, stream);
    if (e != hipSuccess) fprintf(stderr, "cooperative launch failed: %s (grid %d)\n", hipGetErrorString(e), grid);
}
```
